# Optimizing an MI355X kernel written in HIP

```python
import math
import jax, jax.numpy as jnp
from jax import lax
import numpy as np

D_MODEL = 2048
BATCH = 8
SEQ = 2048
DEPTH = 1

CTX_LEN = 256
GRID_W = 64
MIX_W = D_MODEL
HY_W = MIX_W // 2
HY_HEADS = 8
S5_W = MIX_W - HY_W
S5_GROUP = 16
S5_GROUPS = S5_W // S5_GROUP
S5_STATE = 64
HY_ORDER = 2
HY_BANDS = 16
HY_EMB = 1 + 2 * HY_BANDS
HY_FFN = 64
HY_DECAY_TARGET = 1e-2
HY_DECAY_FAST = 0.3
HY_DECAY_SLOW = 1.5
SHORT_K = 3
D_FF = -(-8 * D_MODEL // (3 * 256)) * 256
EPS = 1e-6

kernel_name = 'hymba_style_hyena_s5_dit_block'


def rmsnorm(x, g):
    xf = x.astype(jnp.float32)
    y = xf * lax.rsqrt(jnp.mean(xf * xf, axis=-1, keepdims=True) + EPS)
    return (y * g.astype(jnp.float32)).astype(x.dtype)


def modulate(h, shift, scale):
    return h * (1.0 + scale) + shift


def short_conv(u, w, b):
    n = u.shape[-2]
    up = jnp.pad(u, [(0, 0)] * (u.ndim - 2) + [(1, 1), (0, 0)])
    return up[..., :n, :] * w[0] + up[..., 1:n + 1, :] * w[1] + up[..., 2:, :] * w[2] + b


def hyena_filters(n, w1, b1, w2, b2, w3, sin_freq, decay):
    pos = jnp.arange(n, dtype=jnp.float32)
    t = pos[:, None] / n
    bands = jnp.linspace(1e-4, HY_BANDS - 1, HY_BANDS, dtype=jnp.float32)
    ang = 2.0 * math.pi * pos[:, None] * bands[None, :] / n
    z = jnp.concatenate([t, jnp.cos(ang), -jnp.sin(ang)], axis=-1)
    h = jnp.sin(sin_freq[0] * (z @ w1 + b1))
    h = jnp.sin(sin_freq[1] * (h @ w2 + b2))
    h = (h @ w3).astype(jnp.float32).reshape(n, HY_ORDER, 2, HY_W)
    h = h * jnp.exp(-t[:, :, None, None] * jnp.abs(decay.astype(jnp.float32)))
    fwd, bwd = h[:, :, 0], h[:, :, 1]
    two = jnp.concatenate([fwd, jnp.zeros((1, HY_ORDER, HY_W), jnp.float32), bwd[1:][::-1]], axis=0)
    return two / (jnp.sum(jnp.abs(two), axis=0, keepdims=True) + EPS)


def fftconv(u, h):
    n = u.shape[1]
    uf = jnp.fft.rfft(u.astype(jnp.float32), n=2 * n, axis=1)
    hf = jnp.fft.rfft(h, n=2 * n, axis=0)
    y = jnp.fft.irfft(uf * hf[None], n=2 * n, axis=1)[:, :n]
    return y.astype(u.dtype)


def hyena_mixer(hy, filt, conv_w, conv_b, bias, rows):
    bsz, n, ch = hy.shape
    if rows is None:
        hs = short_conv(hy, conv_w, conv_b)
    else:
        hs = short_conv(hy.reshape(bsz, rows, GRID_W, ch), conv_w, conv_b).reshape(bsz, n, ch)
    v, x1, x2 = jnp.split(hs, 3, axis=-1)
    z = v
    for o, gate in enumerate((x1, x2)):
        z = gate * (fftconv(z, filt[:, o]) + bias[o] * z)
    return z


def _lin_rec(e1, e2):
    a1, b1 = e1
    a2, b2 = e2
    return a1 * a2, a2 * b1 + b2


def s5_direction(ug, lam_re, lam_im, log_dt, b_re, b_im, x0, reverse):
    lam = lax.complex(lam_re.astype(jnp.float32), lam_im.astype(jnp.float32))
    lam_dt = lam * jnp.exp(log_dt.astype(jnp.float32))[:, None]
    a_bar = jnp.exp(lam_dt)
    b_bar = ((a_bar - 1.0) / lam)[..., None] * lax.complex(b_re.astype(jnp.float32), b_im.astype(jnp.float32))
    bu = jnp.einsum('gpc,blgc->blgp', b_bar, ug.astype(jnp.complex64))
    n = ug.shape[1]
    a = jnp.broadcast_to(a_bar, (1, n) + a_bar.shape)
    _, xs = lax.associative_scan(_lin_rec, (a, bu), axis=1, reverse=reverse)
    if x0 is not None:
        steps = jnp.arange(n, dtype=jnp.float32)
        k = (n - steps) if reverse else (steps + 1.0)
        xs = xs + jnp.exp(lam_dt[None] * k[:, None, None])[None] * x0[:, None]
    final = xs[:, 0] if reverse else xs[:, -1]
    return xs, final


def s5_readout(ug, xs_f, xs_b, c_re, c_im, d, glu_w, glu_b, out_dtype):
    cf = lax.complex(c_re[0].astype(jnp.float32), c_im[0].astype(jnp.float32))
    cb = lax.complex(c_re[1].astype(jnp.float32), c_im[1].astype(jnp.float32))
    y = (jnp.einsum('gcp,blgp->blgc', cf, xs_f).real
         + jnp.einsum('gcp,blgp->blgc', cb, xs_b).real
         + d.astype(jnp.float32) * ug)
    bsz, n = ug.shape[:2]
    y = jax.nn.gelu(y).reshape(bsz, n, S5_W).astype(out_dtype)
    gl = y @ glu_w + glu_b
    return gl[..., :S5_W] * jax.nn.sigmoid(gl[..., S5_W:])


def swiglu(h, wg, wu, wd):
    return (jax.nn.silu(h @ wg) * (h @ wu)) @ wd


def setup_inputs(seed: int = 0) -> dict:
    key = jax.random.key(seed)
    ks = iter(jax.random.split(key, 48))
    f32 = jnp.float32

    def nrm(shape, scale):
        return scale * jax.random.normal(next(ks), shape, f32)

    def gain(shape):
        return 1.0 + nrm(shape, 0.02)

    L, D, G, P = DEPTH, D_MODEL, S5_GROUPS, S5_STATE
    x = nrm((BATCH, SEQ, D), 1.0)
    c = nrm((BATCH, D), 1.0)
    ctx = nrm((BATCH, CTX_LEN, D), 1.0)
    c_ctx = nrm((D,), 1.0)
    ada_w = nrm((L, D, 6 * D), 0.5 * D ** -0.5)
    ada_b = nrm((L, 6 * D), 0.01)
    norm1_g = gain((L, D))
    w_in = nrm((L, D, S5_W + 3 * HY_W), D ** -0.5)
    conv_w = nrm((L, SHORT_K, 3 * HY_W), SHORT_K ** -0.5)
    conv_b = nrm((L, 3 * HY_W), 0.01)
    hy_w1 = nrm((L, HY_EMB, HY_FFN), HY_EMB ** -0.5)
    hy_b1 = nrm((L, HY_FFN), 0.02)
    hy_w2 = nrm((L, HY_FFN, HY_FFN), HY_FFN ** -0.5)
    hy_b2 = nrm((L, HY_FFN), 0.02)
    hy_w3 = nrm((L, HY_FFN, HY_ORDER * 2 * HY_W), HY_FFN ** -0.5)
    hy_sin_freq = 1.0 + nrm((L, 2, HY_FFN), 0.1)
    decay_base = jnp.abs(jnp.linspace(math.log(HY_DECAY_TARGET) / HY_DECAY_FAST,
                                      math.log(HY_DECAY_TARGET) / HY_DECAY_SLOW, HY_W, dtype=f32))
    hy_decay = decay_base * (1.0 + nrm((L, HY_ORDER, 2, HY_W), 0.05))
    hy_bias = nrm((L, HY_ORDER, HY_W), 0.5)
    s5_lam_re = -0.5 + nrm((L, 2, G, P), 0.01)
    s5_lam_im = jnp.broadcast_to(math.pi * jnp.arange(P, dtype=f32), (L, 2, G, P)) + nrm((L, 2, G, P), 0.001)
    s5_log_dt = jax.random.uniform(next(ks), (L, 2, G), f32, math.log(1e-3), math.log(1e-1))
    s5_b_re = nrm((L, 2, G, P, S5_GROUP), (2 * S5_GROUP) ** -0.5)
    s5_b_im = nrm((L, 2, G, P, S5_GROUP), (2 * S5_GROUP) ** -0.5)
    s5_c_re = nrm((L, 2, G, S5_GROUP, P), (2 * P) ** -0.5)
    s5_c_im = nrm((L, 2, G, S5_GROUP, P), (2 * P) ** -0.5)
    s5_d = nrm((L, G, S5_GROUP), 1.0)
    s5_glu_w = nrm((L, S5_W, 2 * S5_W), S5_W ** -0.5)
    s5_glu_b = nrm((L, 2 * S5_W), 0.01)
    branch_g_s5 = gain((L, S5_W))
    branch_g_hy = gain((L, HY_W))
    w_out = nrm((L, MIX_W, D), MIX_W ** -0.5)
    norm2_g = gain((L, D))
    ffn_w_gate = nrm((L, D, D_FF), D ** -0.5)
    ffn_w_up = nrm((L, D, D_FF), D ** -0.5)
    ffn_w_down = nrm((L, D_FF, D), D_FF ** -0.5)
    final_g = gain((D,))
    return {'x': x, 'c': c, 'ctx': ctx, 'c_ctx': c_ctx, 'ada_w': ada_w, 'ada_b': ada_b,
            'norm1_g': norm1_g, 'w_in': w_in, 'conv_w': conv_w, 'conv_b': conv_b,
            'hy_w1': hy_w1, 'hy_b1': hy_b1, 'hy_w2': hy_w2, 'hy_b2': hy_b2, 'hy_w3': hy_w3,
            'hy_sin_freq': hy_sin_freq, 'hy_decay': hy_decay, 'hy_bias': hy_bias,
            's5_lam_re': s5_lam_re, 's5_lam_im': s5_lam_im, 's5_log_dt': s5_log_dt,
            's5_b_re': s5_b_re, 's5_b_im': s5_b_im, 's5_c_re': s5_c_re, 's5_c_im': s5_c_im,
            's5_d': s5_d, 's5_glu_w': s5_glu_w, 's5_glu_b': s5_glu_b,
            'branch_g_s5': branch_g_s5, 'branch_g_hy': branch_g_hy, 'w_out': w_out,
            'norm2_g': norm2_g, 'ffn_w_gate': ffn_w_gate, 'ffn_w_up': ffn_w_up,
            'ffn_w_down': ffn_w_down, 'final_g': final_g}


def reference(x, c, ctx, c_ctx, ada_w, ada_b, norm1_g, w_in, conv_w, conv_b,
              hy_w1, hy_b1, hy_w2, hy_b2, hy_w3, hy_sin_freq, hy_decay, hy_bias,
              s5_lam_re, s5_lam_im, s5_log_dt, s5_b_re, s5_b_im, s5_c_re, s5_c_im,
              s5_d, s5_glu_w, s5_glu_b, branch_g_s5, branch_g_hy, w_out,
              norm2_g, ffn_w_gate, ffn_w_up, ffn_w_down, final_g):
    bsz, n_lat, _ = x.shape
    n_ctx = ctx.shape[1]
    rows = n_lat // GRID_W
    for l in range(DEPTH):
        last = l == DEPTH - 1
        mod = jax.nn.silu(c) @ ada_w[l] + ada_b[l]
        mod_c = jax.nn.silu(c_ctx) @ ada_w[l] + ada_b[l]
        sh1, sc1, g1, sh2, sc2, g2 = jnp.split(mod[:, None, :], 6, axis=-1)
        csh1, csc1, cg1, csh2, csc2, cg2 = jnp.split(mod_c, 6, axis=-1)
        s5_fwd = (s5_lam_re[l, 0], s5_lam_im[l, 0], s5_log_dt[l, 0], s5_b_re[l, 0], s5_b_im[l, 0])
        s5_bwd = (s5_lam_re[l, 1], s5_lam_im[l, 1], s5_log_dt[l, 1], s5_b_re[l, 1], s5_b_im[l, 1])

        hc = modulate(rmsnorm(ctx, norm1_g[l]), csh1, csc1)
        pc = hc @ (w_in[l, :, :S5_W] if last else w_in[l])
        ugc = pc[..., :S5_W].astype(jnp.float32).reshape(bsz, n_ctx, S5_GROUPS, S5_GROUP)
        xs_cf, fin_f = s5_direction(ugc, *s5_fwd, None, False)
        xs_cb, fin_b = s5_direction(ugc, *s5_bwd, None, True)

        h = modulate(rmsnorm(x, norm1_g[l]), sh1, sc1)
        p = h @ w_in[l]
        ug = p[..., :S5_W].astype(jnp.float32).reshape(bsz, n_lat, S5_GROUPS, S5_GROUP)
        xs_f, _ = s5_direction(ug, *s5_fwd, fin_f, False)
        xs_b, _ = s5_direction(ug, *s5_bwd, fin_b, True)
        y_s5 = s5_readout(ug, xs_f, xs_b, s5_c_re[l], s5_c_im[l], s5_d[l], s5_glu_w[l], s5_glu_b[l], x.dtype)
        filt = hyena_filters(n_lat, hy_w1[l], hy_b1[l], hy_w2[l], hy_b2[l], hy_w3[l], hy_sin_freq[l], hy_decay[l])
        y_hy = hyena_mixer(p[..., S5_W:], filt, conv_w[l], conv_b[l], hy_bias[l], rows)
        mix = jnp.concatenate([rmsnorm(y_s5, branch_g_s5[l]), rmsnorm(y_hy, branch_g_hy[l])], axis=-1)
        x = x + g1 * (mix @ w_out[l])

        h2 = modulate(rmsnorm(x, norm2_g[l]), sh2, sc2)
        x = x + g2 * swiglu(h2, ffn_w_gate[l], ffn_w_up[l], ffn_w_down[l])

        if not last:
            yc_s5 = s5_readout(ugc, xs_cf, xs_cb, s5_c_re[l], s5_c_im[l], s5_d[l], s5_glu_w[l], s5_glu_b[l], ctx.dtype)
            filt_c = hyena_filters(n_ctx, hy_w1[l], hy_b1[l], hy_w2[l], hy_b2[l], hy_w3[l], hy_sin_freq[l], hy_decay[l])
            yc_hy = hyena_mixer(pc[..., S5_W:], filt_c, conv_w[l], conv_b[l], hy_bias[l], None)
            mixc = jnp.concatenate([rmsnorm(yc_s5, branch_g_s5[l]), rmsnorm(yc_hy, branch_g_hy[l])], axis=-1)
            ctx = ctx + cg1 * (mixc @ w_out[l])
            hc2 = modulate(rmsnorm(ctx, norm2_g[l]), csh2, csc2)
            ctx = ctx + cg2 * swiglu(hc2, ffn_w_gate[l], ffn_w_up[l], ffn_w_down[l])
    return rmsnorm(x, final_g)
```

```cpp
#include <hip/hip_runtime.h>
#include <hip/hip_cooperative_groups.h>
#include <cstdio>
namespace cg = cooperative_groups;

#ifndef ONE_LAUNCH
#define ONE_LAUNCH 1
#endif

#define LAS __attribute__((address_space(3)))
typedef unsigned short bf16_t;
typedef short bf16x8 __attribute__((ext_vector_type(8)));
typedef short bf16x4 __attribute__((ext_vector_type(4)));
typedef float f32x4 __attribute__((ext_vector_type(4)));
typedef float f32x2 __attribute__((ext_vector_type(2)));
typedef unsigned u32x4 __attribute__((ext_vector_type(4)));
typedef unsigned u32x2 __attribute__((ext_vector_type(2)));

constexpr int NTHR = 512;
constexpr int LDS_BYTES = 147456;
constexpr int NPHASE = 11;

constexpr int DM = 2048, NB = 8, SEQ = 2048, CTX = 256, NTOK = NB * SEQ, NCTX = NB * CTX, NROWS = NTOK + NCTX;
constexpr int DFF = 5632;

constexpr size_t WB_IN = 0;
constexpr size_t WB_GLU = WB_IN + (size_t)4096 * 2048 * 2;
constexpr size_t WB_OUT = WB_GLU + (size_t)2048 * 1024 * 2;
constexpr size_t WB_GU = WB_OUT + (size_t)2048 * 2048 * 2;
constexpr size_t WB_DN = WB_GU + (size_t)11264 * 2048 * 2;
constexpr size_t ACT_A = WB_DN + (size_t)2048 * 5632 * 2;
constexpr size_t U_S5 = ACT_A + (size_t)NROWS * 2048 * 2;
constexpr size_t PT_HY = U_S5 + (size_t)64 * NROWS * 16 * 2;
constexpr size_t YT_HY = PT_HY + (size_t)3072 * NTOK * 2;
constexpr size_t YPRE = YT_HY + (size_t)1024 * NTOK * 2;
constexpr size_t HID = U_S5;
constexpr size_t PBUF = YPRE + (size_t)NTOK * 1024 * 2;
constexpr size_t HG = PBUF + (size_t)NTOK * 1024 * 4;
constexpr size_t MODP = HG + (size_t)2 * 1024 * 4096 * 2;
constexpr size_t MODF = MODP + (size_t)8 * 9 * 12288 * 4;
constexpr size_t H2F = MODF + (size_t)9 * 12288 * 4;
constexpr size_t CTR = H2F + (size_t)2048 * 64 * 4;
constexpr size_t WS_BAR = CTR + 256;
constexpr int XCD_BAR_WORDS = 3456;
constexpr size_t WS_END = WS_BAR + (size_t)XCD_BAR_WORDS * 4;
static_assert(HID + (size_t)NTOK * DFF * 2 <= PBUF, "hidden alias");

struct Params { const float* in[36]; float* out; unsigned char* ws; int ph_lo, ph_hi; };

typedef __bf16 bf16v2_t __attribute__((ext_vector_type(2)));
__device__ __forceinline__ unsigned pk_bf16(float lo, float hi) { const f32x2 v = (f32x2){lo, hi}; const bf16v2_t b = __builtin_convertvector(v, bf16v2_t); unsigned r; __builtin_memcpy(&r, &b, 4); return r; }
__device__ __forceinline__ bf16_t f2bf(float f) { return (bf16_t)(pk_bf16(f, 0.f) & 0xffffu); }
__device__ __forceinline__ float bf2f(unsigned b) { return __uint_as_float(b << 16); }
__device__ __forceinline__ float bflo(unsigned w) { return __uint_as_float(w << 16); }
__device__ __forceinline__ float bfhi(unsigned w) { return __uint_as_float(w & 0xffff0000u); }
__device__ __forceinline__ float wave_sum(float v) { for (int o = 32; o; o >>= 1) v += __shfl_xor(v, o); return v; }
__device__ __forceinline__ float sigmoidf_(float x) { return __builtin_amdgcn_rcpf(1.0f + __builtin_amdgcn_exp2f(-1.4426950408889634f * x)); }
__device__ __forceinline__ float gelu_tanh(float x) { const float u = 0.7978845608028654f * (x + 0.044715f * x * x * x); const float e = __builtin_amdgcn_exp2f(2.8853900817779268f * u); return x * (1.0f - __builtin_amdgcn_rcpf(1.0f + e)); }

namespace pg8 {
constexpr int BM = 256, BK = 64, HALF = 128, HTB = HALF * BK * 2, STAGE_BYTES = 8 * HTB, NXCD = 8, WGM = 8;
__device__ __forceinline__ int lds_byte(int r, int c) { const int st = (r >> 4) * 2 + (c >> 5), rr = r & 15, cc = c & 31, ob = rr * 64 + cc * 2; return st * 1024 + (ob ^ (((ob >> 9) & 1) << 5)); }
__device__ __forceinline__ void stage_rc(int b, int& R, int& C) { const int st = b / 1024, sb = b % 1024, swz = sb ^ (((sb >> 9) & 1) << 5); R = (st >> 1) * 16 + swz / 64; C = (st & 1) * 32 + (swz % 64) / 2; }
__device__ __forceinline__ int perm32(int rho) { const int n = rho >> 4, i = rho & 15; return 8 * (i >> 2) + 4 * n + (i & 3); }
struct Unit { int pm, pn; };
struct Gemm { const bf16_t* A; const bf16_t* Bt; int M, N, K; };

struct StaticOrder {
    int nM, nN, nwg, G, c, extra;
    __device__ void init(int M, int N, int G_, int c_, int extra_) { nM = M / BM; nN = N / BM; nwg = nM * nN; G = G_; c = c_; extra = extra_; }
    __device__ bool next(int i, Unit& u) const {
        const long L = (long)i * G + c;
        if (L >= nwg) { const int j = (int)(L - nwg); if (j >= extra) return false; u.pm = nM + (j & 7); u.pn = j >> 3; return true; }
        int wgid = (int)L; { const int q = nwg / NXCD, r = nwg % NXCD, xcd = wgid % NXCD, off = wgid / NXCD; wgid = (xcd < r ? xcd * (q + 1) : r * (q + 1) + (xcd - r) * q) + off; }
        const int nig = WGM * nN, gid = wgid / nig, fm = gid * WGM, gsz = (nM - fm) < WGM ? (nM - fm) : WGM;
        u.pm = fm + ((wgid % nig) % gsz); u.pn = (wgid % nig) / gsz; return true;
    }
};

template <class Epi>
__device__ __forceinline__ void gemm_phase(LAS unsigned char* lds, const Gemm g, const StaticOrder& S, const Epi& E) {
    const int tid = threadIdx.x, wid = __builtin_amdgcn_readfirstlane(tid >> 6), lane = tid & 63, wr = wid >> 2, wc = wid & 3, fr = lane & 15, fq = lane >> 4;
    const int K = g.K, nt = K / BK;
    unsigned voffA[2], voffB[2];
#pragma unroll
    for (int i = 0; i < 2; ++i) { int R, C; stage_rc(tid * 16 + i * 8192, R, C); const int Rb = Epi::PERM ? ((R & ~31) + perm32(R & 31)) : R;
        voffA[i] = (unsigned)(R * K + C) * 2u; voffB[i] = (unsigned)(Rb * K + C) * 2u; }
    const size_t kstep = (size_t)(BK * 2);
    const size_t hstep = (size_t)HALF * K * 2;
    const size_t tstep = 2 * hstep;
    const unsigned ldsw = (unsigned)wid * 1024u;
    const int aoff = lds_byte(wr * 64 + fr, fq * 8), boff = lds_byte(wc * 32 + fr, fq * 8);
#define PG8_SA(b, h) (((b) * 2 + (h)) * HTB)
#define PG8_SB(b, h) ((4 + (b) * 2 + (h)) * HTB)
#define PG8_STAGE(bufoff, gbase, voff) do { _Pragma("unroll") for (int _i = 0; _i < 2; ++_i) \
        __builtin_amdgcn_global_load_lds((const unsigned*)((const char*)(gbase) + (voff)[_i]), (LAS unsigned*)(lds + (bufoff) + ldsw + _i * 8192), 16, 0, 0); } while (0)
#define PG8_LDA(dst, b, h) do { _Pragma("unroll") for (int m = 0; m < 4; ++m) _Pragma("unroll") for (int k = 0; k < 2; ++k) dst[m][k] = *(const LAS bf16x8*)(lds + PG8_SA(b, h) + aoff + m * 2048 + k * 1024); } while (0)
#define PG8_LDB(dst, b, h) do { _Pragma("unroll") for (int n = 0; n < 2; ++n) _Pragma("unroll") for (int k = 0; k < 2; ++k) dst[n][k] = *(const LAS bf16x8*)(lds + PG8_SB(b, h) + boff + n * 2048 + k * 1024); } while (0)
#define PG8_MMA(ai, bj, At, Bt) do { __builtin_amdgcn_s_setprio(1); _Pragma("unroll") for (int m = 0; m < 4; ++m) _Pragma("unroll") for (int n = 0; n < 2; ++n) _Pragma("unroll") for (int k = 0; k < 2; ++k) \
        acc[ai][bj][m][n] = __builtin_amdgcn_mfma_f32_16x16x32_bf16(Bt[n][k], At[m][k], acc[ai][bj][m][n], 0, 0, 0); __builtin_amdgcn_s_setprio(0); } while (0)
#define PG8_WAIT_V(n) asm volatile("s_waitcnt vmcnt(" #n ")" ::: "memory")
#define PG8_WAIT_L(n) asm volatile("s_waitcnt lgkmcnt(" #n ")" ::: "memory")
#define PG8_BAR __builtin_amdgcn_s_barrier()
#define PG8_SCHED __builtin_amdgcn_sched_barrier(0)
    Unit cur, nxt; int ui = 0;
    if (!S.next(0, cur)) return;
    f32x4 acc[2][2][4][2];
#pragma unroll
    for (int a = 0; a < 2; ++a)
#pragma unroll
        for (int b = 0; b < 2; ++b)
#pragma unroll
            for (int m = 0; m < 4; ++m)
#pragma unroll
                for (int n = 0; n < 2; ++n) acc[a][b][m][n] = (f32x4){0.f, 0.f, 0.f, 0.f};
    bf16x8 At[4][2], B0[2][2], B1[2][2];
    const char* cA = (const char*)g.A + (size_t)cur.pm * tstep; const char* cB = (const char*)g.Bt + (size_t)cur.pn * tstep;
    PG8_STAGE(PG8_SB(0, 0), cB, voffB); PG8_STAGE(PG8_SA(0, 0), cA, voffA); PG8_STAGE(PG8_SB(0, 1), cB + hstep, voffB); PG8_STAGE(PG8_SA(0, 1), cA + hstep, voffA);
    if (wr == 1) PG8_BAR;
    PG8_WAIT_V(4); PG8_BAR;
    PG8_STAGE(PG8_SB(1, 0), cB + kstep, voffB); PG8_STAGE(PG8_SA(1, 0), cA + kstep, voffA); PG8_STAGE(PG8_SB(1, 1), cB + hstep + kstep, voffB);
    PG8_WAIT_V(6); PG8_BAR;
    for (;;) {
        const bool has_next = S.next(ui + 1, nxt);
        const char* nA = has_next ? (const char*)g.A + (size_t)nxt.pm * tstep : cA; const char* nB = has_next ? (const char*)g.Bt + (size_t)nxt.pn * tstep : cB;
        for (int t = 0; t < nt; t += 2) {
            const bool last = (t == nt - 2);
            const char* a1 = cA + (size_t)(t + 1) * kstep;
            const char* a2 = last ? nA : cA + (size_t)(t + 2) * kstep; const char* b2 = last ? nB : cB + (size_t)(t + 2) * kstep;
            const char* a3 = a2 + kstep; const char* b3 = b2 + kstep;
            PG8_LDB(B0, 0, 0); PG8_SCHED; PG8_LDA(At, 0, 0); PG8_STAGE(PG8_SA(1, 1), a1 + hstep, voffA);
            PG8_WAIT_L(8); PG8_BAR; PG8_WAIT_L(0); PG8_MMA(0, 0, At, B0); PG8_BAR; PG8_SCHED;
            PG8_LDB(B1, 0, 1); PG8_STAGE(PG8_SB(0, 0), b2, voffB);
            PG8_BAR; PG8_WAIT_L(0); PG8_MMA(0, 1, At, B1); PG8_BAR;
            PG8_LDA(At, 0, 1); PG8_STAGE(PG8_SA(0, 0), a2, voffA);
            PG8_BAR; PG8_WAIT_L(0); PG8_MMA(1, 0, At, B0); PG8_BAR; PG8_SCHED;
            PG8_STAGE(PG8_SB(0, 1), b2 + hstep, voffB);
            PG8_WAIT_V(6); PG8_BAR; PG8_MMA(1, 1, At, B1); PG8_BAR;
            PG8_LDB(B0, 1, 0); PG8_SCHED; PG8_LDA(At, 1, 0); PG8_STAGE(PG8_SA(0, 1), a2 + hstep, voffA);
            PG8_WAIT_L(8); PG8_BAR; PG8_WAIT_L(0); PG8_MMA(0, 0, At, B0); PG8_BAR; PG8_SCHED;
            PG8_LDB(B1, 1, 1); PG8_STAGE(PG8_SB(1, 0), b3, voffB);
            PG8_BAR; PG8_WAIT_L(0); PG8_MMA(0, 1, At, B1); PG8_BAR;
            PG8_LDA(At, 1, 1); PG8_STAGE(PG8_SA(1, 0), a3, voffA);
            PG8_BAR; PG8_WAIT_L(0); PG8_MMA(1, 0, At, B0); PG8_BAR; PG8_SCHED;
            PG8_STAGE(PG8_SB(1, 1), b3 + hstep, voffB);
            PG8_WAIT_V(6); PG8_BAR; PG8_MMA(1, 1, At, B1); PG8_BAR;
        }
        E(acc, cur, wr, wc, fr, fq);
        if (!has_next) break;
#pragma unroll
        for (int a = 0; a < 2; ++a)
#pragma unroll
            for (int b = 0; b < 2; ++b)
#pragma unroll
                for (int m = 0; m < 4; ++m)
#pragma unroll
                    for (int n = 0; n < 2; ++n) acc[a][b][m][n] = (f32x4){0.f, 0.f, 0.f, 0.f};
        cur = nxt; cA = nA; cB = nB; ++ui;
    }
    PG8_WAIT_V(0);
    if (wr == 0) PG8_BAR;
    PG8_BAR;
#undef PG8_SA
#undef PG8_SB
#undef PG8_STAGE
#undef PG8_LDA
#undef PG8_LDB
#undef PG8_MMA
#undef PG8_WAIT_V
#undef PG8_WAIT_L
#undef PG8_BAR
#undef PG8_SCHED
}

struct EpiInProj {
    static constexpr bool PERM = true;
    bf16_t* U; bf16_t* PT;
    __device__ __forceinline__ void operator()(const f32x4 (&acc)[2][2][4][2], const Unit& u, int wr, int wc, int fr, int fq) const {
        const int row0 = u.pm * BM + wr * 64 + fr, colb = u.pn * BM + wc * 32 + 8 * fq;
#pragma unroll
        for (int ai = 0; ai < 2; ++ai)
#pragma unroll
            for (int m = 0; m < 4; ++m) { const int row = row0 + ai * HALF + m * 16;
#pragma unroll
                for (int bj = 0; bj < 2; ++bj) { const int col = colb + bj * HALF; const f32x4 v0 = acc[ai][bj][m][0], v1 = acc[ai][bj][m][1];
                    if (u.pn < 4) { u32x4 w; w.x = pk_bf16(v0[0], v0[1]); w.y = pk_bf16(v0[2], v0[3]); w.z = pk_bf16(v1[0], v1[1]); w.w = pk_bf16(v1[2], v1[3]);
                        *(u32x4*)(U + ((size_t)(col >> 4) * NROWS + row) * 16 + (col & 15)) = w; }
                    else { bf16_t* p = PT + (size_t)(col - 1024) * NTOK + row;
#pragma unroll
                        for (int j = 0; j < 4; ++j) { p[(size_t)j * NTOK] = f2bf(v0[j]); p[(size_t)(4 + j) * NTOK] = f2bf(v1[j]); } } } }
    }
};
template <int KIND  > struct EpiGate {
    static constexpr bool PERM = true;
    bf16_t* O; int ldo; const float* bias; int boff;
    __device__ __forceinline__ void operator()(const f32x4 (&acc)[2][2][4][2], const Unit& u, int wr, int wc, int fr, int fq) const {
        const int row0 = u.pm * BM + wr * 64 + fr, col0 = u.pn * HALF + wc * 32 + 8 * fq;
        f32x4 ba[2], bb[2];
#pragma unroll
        for (int n = 0; n < 2; ++n) { if (KIND == 0) { ba[n] = *(const f32x4*)(bias + col0 + 4 * n); bb[n] = *(const f32x4*)(bias + boff + col0 + 4 * n); } else { ba[n] = (f32x4){0.f, 0.f, 0.f, 0.f}; bb[n] = ba[n]; } }
#pragma unroll
        for (int ai = 0; ai < 2; ++ai)
#pragma unroll
            for (int m = 0; m < 4; ++m) { const int row = row0 + ai * HALF + m * 16; float o[8];
#pragma unroll
                for (int n = 0; n < 2; ++n)
#pragma unroll
                    for (int j = 0; j < 4; ++j) { const float a = acc[ai][0][m][n][j] + ba[n][j], b = acc[ai][1][m][n][j] + bb[n][j];
                        o[4 * n + j] = (KIND == 0) ? a * sigmoidf_(b) : (a * sigmoidf_(a)) * b; }
                u32x4 w; w.x = pk_bf16(o[0], o[1]); w.y = pk_bf16(o[2], o[3]); w.z = pk_bf16(o[4], o[5]); w.w = pk_bf16(o[6], o[7]);
                *(u32x4*)(O + (size_t)row * ldo + col0) = w; }
    }
};
template <bool RES_BF16> struct EpiRes {
    static constexpr bool PERM = false;
    const void* res; bf16_t* out; const float* gate;
    __device__ __forceinline__ void operator()(const f32x4 (&acc)[2][2][4][2], const Unit& u, int wr, int wc, int fr, int fq) const {
        const int row0 = u.pm * BM + wr * 64 + fr, col0 = u.pn * BM + wc * 32 + 4 * fq;
        const float* gp = gate + (size_t)(u.pm >> 3) * 12288 + col0;
        f32x4 gv[2][2];
#pragma unroll
        for (int bj = 0; bj < 2; ++bj)
#pragma unroll
            for (int n = 0; n < 2; ++n) gv[bj][n] = *(const f32x4*)(gp + bj * HALF + n * 16);
#pragma unroll
        for (int ai = 0; ai < 2; ++ai)
#pragma unroll
            for (int m = 0; m < 4; ++m) { const size_t ro = (size_t)(row0 + ai * HALF + m * 16) * DM + col0;
#pragma unroll
                for (int bj = 0; bj < 2; ++bj)
#pragma unroll
                    for (int n = 0; n < 2; ++n) { const size_t o = ro + bj * HALF + n * 16; f32x4 r;
                        if (RES_BF16) { const u32x2 rb = *(const u32x2*)((const bf16_t*)res + o); r = (f32x4){bflo(rb.x), bfhi(rb.x), bflo(rb.y), bfhi(rb.y)}; }
                        else r = *(const f32x4*)((const float*)res + o);
                        const f32x4 v = r + gv[bj][n] * acc[ai][bj][m][n];
                        u32x2 wv; wv.x = pk_bf16(v[0], v[1]); wv.y = pk_bf16(v[2], v[3]); *(u32x2*)(out + o) = wv; } }
    }
};
}

#define XB_TMO      128
#define XB_XCNT(j)  (256  + 64 * (j))
#define XB_XSUB(j)  (1280 + 64 * (j))
#define XB_XGEN(j)  (2304 + 64 * (j))
#define XB_TOP      3328
#define XB_TOPGEN   3392
#define XB_SPIN_CAP (1u << 22)
__device__ __forceinline__ unsigned xb_ld(unsigned* p)              { return __hip_atomic_load(p, __ATOMIC_RELAXED, __HIP_MEMORY_SCOPE_AGENT); }
__device__ __forceinline__ unsigned xb_add(unsigned* p, unsigned v) { return __hip_atomic_fetch_add(p, v, __ATOMIC_RELAXED, __HIP_MEMORY_SCOPE_AGENT); }
__device__ __forceinline__ unsigned xb_xcc_id() { return (unsigned)__builtin_amdgcn_s_getreg((3 << 11) | 20) & 0xFu; }
#define XB_SPIN(cond, bar) do { unsigned _sp = 0; while (cond) { __builtin_amdgcn_s_sleep(1); \
    if ((++_sp & 255u) == 0u) { if (xb_ld(&(bar)[XB_TMO])) break; if (_sp > XB_SPIN_CAP) { atomicAdd(&(bar)[XB_TMO], 1u); break; } } } } while (0)
struct XcdBarrier { unsigned* bar; unsigned x; volatile LAS unsigned* st; };
__device__ __forceinline__ XcdBarrier xcd_barrier_post(unsigned* bar, volatile LAS unsigned* st) {
    XcdBarrier b; b.bar = bar; b.x = xb_xcc_id(); b.st = st;
    if (threadIdx.x == 0) (void)xb_add(&bar[XB_XCNT(b.x)], 1u);
    return b;
}
__device__ __forceinline__ void xcd_barrier_complete(unsigned* bar, unsigned x, unsigned& nloc, unsigned& nx) {
    const unsigned G = gridDim.x * gridDim.y * gridDim.z;
    unsigned sum, cnt, mine, sp = 0u;
    for (;;) {
        sum = 0u; cnt = 0u; mine = 0u;
#pragma unroll
        for (unsigned j = 0; j < 16; ++j) { const unsigned c = xb_ld(&bar[XB_XCNT(j)]); sum += c; cnt += (c > 0u) ? 1u : 0u; mine = (j == x) ? c : mine; }
        if (sum == G) break;
        __builtin_amdgcn_s_sleep(1);
        if ((++sp & 255u) == 0u) { if (xb_ld(&bar[XB_TMO])) break; if (sp > XB_SPIN_CAP) { atomicAdd(&bar[XB_TMO], 1u); break; } }
    }
    nloc = mine > 0u ? mine : 1u; nx = cnt > 0u ? cnt : 1u;
}
__device__ __forceinline__ void xcd_barrier(const XcdBarrier& b) {
    asm volatile("s_waitcnt vmcnt(0)" ::: "memory");
    __syncthreads();
    if (threadIdx.x == 0) {
        unsigned* bar = b.bar;
        __builtin_amdgcn_s_waitcnt(0);
        unsigned nloc = b.st[0], nx = b.st[1];
        if (nloc == 0u) { xcd_barrier_complete(bar, b.x, nloc, nx); b.st[0] = nloc; b.st[1] = nx; }
        const unsigned old = xb_add(&bar[XB_XSUB(b.x)], 1u);
        const unsigned gen = old / nloc;
        if (old + 1u == (gen + 1u) * nloc) {
            __builtin_amdgcn_fence(__ATOMIC_RELEASE, "agent");
            asm volatile("s_waitcnt vmcnt(0)" ::: "memory");
            const unsigned og = xb_add(&bar[XB_TOP], 1u);
            const unsigned tg = og / nx;
            if (og + 1u == (tg + 1u) * nx) xb_add(&bar[XB_TOPGEN], 1u);
            else XB_SPIN(xb_ld(&bar[XB_TOPGEN]) == tg, bar);
            __builtin_amdgcn_fence(__ATOMIC_ACQUIRE, "agent");
            xb_add(&bar[XB_XGEN(b.x)], 1u);
            asm volatile("s_waitcnt vmcnt(0)" ::: "memory");
        } else {
            XB_SPIN(xb_ld(&bar[XB_XGEN(b.x)]) == gen, bar);
            __builtin_amdgcn_fence(__ATOMIC_ACQUIRE, "agent");
            asm volatile("s_waitcnt vmcnt(0)" ::: "memory");
        }
    }
    __syncthreads();
}

__device__ __forceinline__ void convert_items(const Params& P, int Tb, int Te, int worker, int nworkers) {
    unsigned char* ws = P.ws; const int lane = threadIdx.x & 63;
    for (int T = Tb + worker; T < Te; T += nworkers) {
        const float* src; int ld, K, k0; bf16_t* dst;
        if (T < 2048) { const int kt = T & 31, r0 = (T >> 5) * 64; src = P.in[7] + r0; ld = 4096; K = 2048; k0 = kt * 64; dst = (bf16_t*)(ws + WB_IN) + (size_t)r0 * K; }
        else if (T < 2560) { const int t2 = T - 2048, kt = t2 & 15, r0 = (t2 >> 4) * 64; const int pn = r0 >> 8, bj = (r0 >> 7) & 1, j0 = r0 & 127;
            src = P.in[26] + bj * 1024 + pn * 128 + j0; ld = 2048; K = 1024; k0 = kt * 64; dst = (bf16_t*)(ws + WB_GLU) + (size_t)r0 * K; }
        else if (T < 3584) { const int t2 = T - 2560, kt = t2 & 31, r0 = (t2 >> 5) * 64; src = P.in[30] + r0; ld = 2048; K = 2048; k0 = kt * 64; dst = (bf16_t*)(ws + WB_OUT) + (size_t)r0 * K; }
        else if (T < 9216) { const int t2 = T - 3584, kt = t2 & 31, r0 = (t2 >> 5) * 64; const int pn = r0 >> 8, bj = (r0 >> 7) & 1, j0 = r0 & 127;
            src = (bj ? P.in[33] : P.in[32]) + pn * 128 + j0; ld = DFF; K = 2048; k0 = kt * 64; dst = (bf16_t*)(ws + WB_GU) + (size_t)r0 * K; }
        else { const int t2 = T - 9216, kt = t2 % 88, r0 = (t2 / 88) * 64; src = P.in[34] + r0; ld = 2048; K = DFF; k0 = kt * 64; dst = (bf16_t*)(ws + WB_DN) + (size_t)r0 * K; }
        const float* sp = src + (size_t)k0 * ld + lane;
        float f[64];
#pragma unroll
        for (int k = 0; k < 64; ++k) f[k] = __builtin_nontemporal_load(sp + (size_t)k * ld);
        bf16_t* dp = dst + (size_t)lane * K + k0;
#pragma unroll
        for (int k8 = 0; k8 < 8; ++k8) { u32x4 wv; wv.x = pk_bf16(f[8 * k8 + 0], f[8 * k8 + 1]); wv.y = pk_bf16(f[8 * k8 + 2], f[8 * k8 + 3]); wv.z = pk_bf16(f[8 * k8 + 4], f[8 * k8 + 5]); wv.w = pk_bf16(f[8 * k8 + 6], f[8 * k8 + 7]);
            if (T >= 3584) __builtin_nontemporal_store(wv, (u32x4*)(dp + 8 * k8)); else *(u32x4*)(dp + 8 * k8) = wv; }
    }
}
__device__ __forceinline__ void phaseA(const Params& P, unsigned char* lds) {
    const int tid = threadIdx.x, bid = blockIdx.x, G = gridDim.x;
    unsigned char* ws = P.ws;
    if (bid == 0 && tid < 32) { ((unsigned*)(ws + CTR))[tid] = (tid < 2) ? (unsigned)gridDim.x : 0u; }
    convert_items(P, 0, 12032, bid * 8 + (tid >> 6), G * 8);
    for (int it = bid; it < 256; it += G) {
        const int jb = it & 31, kb = it >> 5;
        float* sl = (float*)lds;
        float* red = sl + 9 * 256;
        for (int idx = tid; idx < 9 * 256; idx += NTHR) { const int row = idx >> 8, kk = idx & 255; const float cv = row < 8 ? P.in[1][row * DM + kb * 256 + kk] : P.in[3][kb * 256 + kk]; sl[idx] = cv / (1.0f + expf(-cv)); }
        __syncthreads();
        if (tid < 384) { const int col4 = tid % 96, rg = tid / 96; f32x4 acc[9];
#pragma unroll
            for (int r = 0; r < 9; ++r) acc[r] = (f32x4){0.f, 0.f, 0.f, 0.f};
            const float* wp = P.in[4] + (size_t)(kb * 256 + rg * 64) * 12288 + jb * 384 + 4 * col4;
#pragma unroll 1
            for (int r0 = 0; r0 < 64; r0 += 8) { f32x4 wv[8];
#pragma unroll
                for (int j = 0; j < 8; ++j) wv[j] = __builtin_nontemporal_load((const f32x4*)(wp + (size_t)(r0 + j) * 12288));
#pragma unroll
                for (int j = 0; j < 8; ++j)
#pragma unroll
                    for (int row = 0; row < 9; ++row) acc[row] += sl[row * 256 + rg * 64 + r0 + j] * wv[j]; }
#pragma unroll
            for (int row = 0; row < 9; ++row) *(f32x4*)(red + (rg * 9 + row) * 384 + 4 * col4) = acc[row]; }
        __syncthreads();
        float* mp = (float*)(ws + MODP);
        for (int idx = tid; idx < 9 * 384; idx += NTHR) { const int row = idx / 384, col = idx % 384; float s = 0.f;
#pragma unroll
            for (int rg = 0; rg < 4; ++rg) s += red[(rg * 9 + row) * 384 + col];
            mp[(size_t)(kb * 9 + row) * 12288 + jb * 384 + col] = s; }
        __syncthreads();
    }
    for (int it = bid; it < 256; it += G) {
        const int t0 = it * 8;
        float* z = (float*)lds;
        float* h1 = z + 8 * 33;
        if (tid < 8 * 33) { const int r = tid / 33, f = tid % 33; const double t = (double)(t0 + r); float v;
            if (f == 0) v = (float)(t / 2048.0);
            else { const int bi = (f - 1) & 15; const double band = 1e-4 + (double)bi * ((15.0 - 1e-4) / 15.0); const double ang = 2.0 * 3.14159265358979323846 * t * band / 2048.0; v = (f <= 16) ? (float)cos(ang) : (float)(-sin(ang)); }
            z[tid] = v; }
        __syncthreads();
        const int r = tid >> 6, j = tid & 63;
        { float s = P.in[11][j]; for (int k = 0; k < 33; ++k) s += z[r * 33 + k] * P.in[10][k * 64 + j]; h1[r * 64 + j] = sinf(P.in[15][j] * s); }
        __syncthreads();
        { float s = P.in[13][j]; for (int k = 0; k < 64; ++k) s += h1[r * 64 + k] * P.in[12][k * 64 + j]; ((float*)(ws + H2F))[(size_t)j * 2048 + t0 + r] = sinf(P.in[15][64 + j] * s); }
        __syncthreads();
    }
}

typedef __attribute__((address_space(1))) unsigned long long gu64_t;
typedef __attribute__((address_space(1))) unsigned gu32_t;
template <bool WT = false> __device__ __forceinline__ void norm_rows_B(const Params& P, const float* xr, bf16_t* orow, const float* sh, const float* sc, int lane) {
    f32x4 v[8]; float ss = 0.f;
#pragma unroll
    for (int q = 0; q < 8; ++q) { v[q] = __builtin_nontemporal_load((const f32x4*)(xr + 4 * (lane + 64 * q))); ss += v[q][0] * v[q][0] + v[q][1] * v[q][1] + v[q][2] * v[q][2] + v[q][3] * v[q][3]; }
    ss = wave_sum(ss); const float r = rsqrtf(ss * (1.0f / DM) + 1e-6f);
#pragma unroll
    for (int q = 0; q < 8; ++q) { const int c0 = 4 * (lane + 64 * q); const f32x4 g = *(const f32x4*)(P.in[6] + c0); const f32x4 s1 = *(const f32x4*)(sc + c0), h1 = *(const f32x4*)(sh + c0);
        float o[4];
#pragma unroll
        for (int e = 0; e < 4; ++e) o[e] = (v[q][e] * r * g[e]) * (1.0f + s1[e]) + h1[e];
        u32x2 wv; wv.x = pk_bf16(o[0], o[1]); wv.y = pk_bf16(o[2], o[3]);
        if (WT) __hip_atomic_store((gu64_t*)(orow + c0), ((unsigned long long)wv.y << 32) | wv.x, __ATOMIC_RELAXED, __HIP_MEMORY_SCOPE_AGENT);
        else *(u32x2*)(orow + c0) = wv; }
}
__device__ __forceinline__ void norm_rows_B2(const Params& P, const float* xr, bf16_t* orow, const float* sh, const float* sc, int lane) {
    f32x4 v[2][8];
#pragma unroll
    for (int u = 0; u < 2; ++u)
#pragma unroll
        for (int q = 0; q < 8; ++q) v[u][q] = __builtin_nontemporal_load((const f32x4*)(xr + (size_t)u * 8 * DM + 4 * (lane + 64 * q)));
#pragma unroll
    for (int u = 0; u < 2; ++u) { float ss = 0.f;
#pragma unroll
        for (int q = 0; q < 8; ++q) ss += v[u][q][0] * v[u][q][0] + v[u][q][1] * v[u][q][1] + v[u][q][2] * v[u][q][2] + v[u][q][3] * v[u][q][3];
        ss = wave_sum(ss); const float r = rsqrtf(ss * (1.0f / DM) + 1e-6f);
#pragma unroll
        for (int q = 0; q < 8; ++q) { const int c0 = 4 * (lane + 64 * q); const f32x4 g = *(const f32x4*)(P.in[6] + c0); const f32x4 s1 = *(const f32x4*)(sc + c0), h1 = *(const f32x4*)(sh + c0);
            float o[4];
#pragma unroll
            for (int e = 0; e < 4; ++e) o[e] = (v[u][q][e] * r * g[e]) * (1.0f + s1[e]) + h1[e];
            u32x2 wv; wv.x = pk_bf16(o[0], o[1]); wv.y = pk_bf16(o[2], o[3]);
            *(u32x2*)(orow + (size_t)u * 8 * DM + c0) = wv; } }
}
__device__ __forceinline__ void load_tab_B(const Params& P, float* tab, int row) {
    const float* mp = (const float*)(P.ws + MODP); const float* ada_b = P.in[5];
#pragma unroll
    for (int q = 0; q < 8; ++q) { const int idx = threadIdx.x + NTHR * q; float s = ada_b[idx];
#pragma unroll
        for (int k = 0; k < 8; ++k) s += mp[(size_t)(k * 9 + row) * 12288 + idx];
        tab[idx] = s; }
}
__device__ __forceinline__ void phaseB(const Params& P, unsigned char* lds_g, LAS unsigned char* lds) {
    const int tid = threadIdx.x, bid = blockIdx.x, G = gridDim.x, w = tid >> 6, lane = tid & 63;
    unsigned char* ws = P.ws;
    const float* mp = (const float*)(ws + MODP);
    const float* ada_b = P.in[5];
    bf16_t* Hn = (bf16_t*)(ws + ACT_A);
    float* tab = (float*)lds_g;
    for (int it = bid; it < 256; it += G)
        for (int idx = tid; idx < 9 * 48; idx += NTHR) { const int row = idx / 48, j = it * 48 + idx % 48; float s = ada_b[j];
#pragma unroll
            for (int k = 0; k < 8; ++k) s += mp[(size_t)(k * 9 + row) * 12288 + j];
            ((float*)(ws + MODF))[(size_t)row * 12288 + j] = s; }
    const int NCB = (G >= 64) ? 32 : 0;
    if (bid < NCB) {
        const int cb = bid & 7;
        load_tab_B(P, tab, 8);
        __syncthreads();
#pragma unroll 2
        for (int r = 0; r < 8; ++r) { const int crow = cb * 256 + (bid >> 3) * 64 + w * 8 + r; norm_rows_B<true>(P, P.in[2] + (size_t)crow * DM, Hn + (size_t)(NTOK + crow) * DM, tab, tab + 2048, lane); }
        asm volatile("s_waitcnt vmcnt(0)" ::: "memory");
        __syncthreads();
        { gu32_t* flag = (gu32_t*)((unsigned*)(ws + CTR) + 8 + cb);
          if (tid == 0) { __hip_atomic_fetch_add(flag, 1u, __ATOMIC_RELAXED, __HIP_MEMORY_SCOPE_AGENT);
              while (__hip_atomic_load(flag, __ATOMIC_RELAXED, __HIP_MEMORY_SCOPE_AGENT) < 4u) __builtin_amdgcn_s_sleep(2);
              __builtin_amdgcn_fence(__ATOMIC_ACQUIRE, "agent"); asm volatile("s_waitcnt vmcnt(0)" ::: "memory"); }
          __syncthreads(); }
        pg8::Gemm g{(const bf16_t*)(ws + ACT_A), (const bf16_t*)(ws + WB_IN), NTOK, 0, 2048}; pg8::StaticOrder S; S.init(NTOK, 0, NCB, bid, 32);
        pg8::EpiInProj E{(bf16_t*)(ws + U_S5), (bf16_t*)(ws + PT_HY)}; pg8::gemm_phase(lds, g, S, E);
        return;
    }
    const int nw = G - NCB, wb = bid - NCB;
    if (NCB == 0) {
        load_tab_B(P, tab, 8); __syncthreads();
        for (int crow = wb * 8 + w; crow < NCTX; crow += nw * 8) norm_rows_B(P, P.in[2] + (size_t)crow * DM, Hn + (size_t)(NTOK + crow) * DM, tab, tab + 2048, lane);
        __syncthreads();
    }
    { const int g0 = (int)((long)wb * 2048 / nw), g1 = (int)((long)(wb + 1) * 2048 / nw); int curb = -1;
      for (int gr = g0; gr < g1; gr += 2) { const int b = gr >> 8;
          if (b != curb) { __syncthreads(); load_tab_B(P, tab, b); __syncthreads(); curb = b; }
          const bool two = (gr + 1 < g1) && (((gr + 1) >> 8) == b);
          const int row = gr * 8 + w;
          if (two) { norm_rows_B2(P, P.in[0] + (size_t)row * DM, Hn + (size_t)row * DM, tab, tab + 2048, lane); }
          else { norm_rows_B(P, P.in[0] + (size_t)row * DM, Hn + (size_t)row * DM, tab, tab + 2048, lane); gr -= 1; } }
      __syncthreads(); }
    for (int it = wb; it < 512; it += nw) {
        const int o = it >> 8, c0 = (it & 255) * 4;
        float* vals = (float*)lds_g;
        float* w3s = vals + 2048 * 8;
        float* red = w3s + 64 * 8;
        float* tot = red + 8 * 8;
        for (int idx = tid; idx < 64 * 8; idx += NTHR) { const int k = idx >> 3, col = idx & 7, dir = col >> 2, ch = col & 3; w3s[idx] = P.in[14][(size_t)k * 4096 + o * 2048 + dir * 1024 + c0 + ch]; }
        __syncthreads();
        float dec[8];
#pragma unroll
        for (int col = 0; col < 8; ++col) dec[col] = fabsf(P.in[16][(o * 2 + (col >> 2)) * 1024 + c0 + (col & 3)]);
        float sabs[8];
#pragma unroll
        for (int col = 0; col < 8; ++col) sabs[col] = 0.f;
        const float* h2f = (const float*)(ws + H2F);
        {
            float a[4][8];
#pragma unroll
            for (int r = 0; r < 4; ++r)
#pragma unroll
                for (int col = 0; col < 8; ++col) a[r][col] = 0.f;
#pragma unroll 1
            for (int k0 = 0; k0 < 64; k0 += 8) { f32x4 hv[8];
#pragma unroll
                for (int kk = 0; kk < 8; ++kk) hv[kk] = *(const f32x4*)(h2f + (size_t)(k0 + kk) * 2048 + 4 * tid);
#pragma unroll
                for (int kk = 0; kk < 8; ++kk) { const f32x4* wr4 = (const f32x4*)(w3s + (k0 + kk) * 8); const f32x4 w0 = wr4[0], w1 = wr4[1];
#pragma unroll
                    for (int r = 0; r < 4; ++r) { const float hk = hv[kk][r];
                        a[r][0] += hk * w0[0]; a[r][1] += hk * w0[1]; a[r][2] += hk * w0[2]; a[r][3] += hk * w0[3];
                        a[r][4] += hk * w1[0]; a[r][5] += hk * w1[1]; a[r][6] += hk * w1[2]; a[r][7] += hk * w1[3]; } } }
#pragma unroll
            for (int r = 0; r < 4; ++r) { const int t = 4 * tid + r; const float tn = (float)t * (1.0f / 2048.0f);
#pragma unroll
                for (int col = 0; col < 8; ++col) { a[r][col] *= expf(-tn * dec[col]); if (col < 4 || t > 0) sabs[col] += fabsf(a[r][col]); }
#pragma unroll
                for (int c4 = 0; c4 < 2; ++c4) *(f32x4*)(vals + t * 8 + 4 * c4) = (f32x4){a[r][4 * c4], a[r][4 * c4 + 1], a[r][4 * c4 + 2], a[r][4 * c4 + 3]}; }
        }
#pragma unroll
        for (int col = 0; col < 8; ++col) { const float sm = wave_sum(sabs[col]); if (lane == 0) red[w * 8 + col] = sm; }
        __syncthreads();
        if (tid < 4) { float sm = 0.f; for (int ww = 0; ww < 8; ++ww) sm += red[ww * 8 + tid] + red[ww * 8 + 4 + tid]; tot[tid] = 1.0f / (sm + 1e-6f); }
        __syncthreads();
        bf16_t* hg = (bf16_t*)(ws + HG) + (size_t)(o * 1024 + c0) * 4096;
#pragma unroll 4
        for (int idx = tid; idx < 2 * 2048 * 4; idx += NTHR) {
            const int t = idx & 2047, ch = (idx >> 11) & 3, dir = idx >> 13;
            const unsigned short v = f2bf(vals[t * 8 + dir * 4 + ch] * tot[ch]);
            if (dir == 0) hg[(size_t)ch * 4096 + 2048 - t] = v; else if (t > 0) hg[(size_t)ch * 4096 + 2048 + t] = v; else hg[(size_t)ch * 4096] = 0;
        }
        __syncthreads();
    }
}

__device__ __forceinline__ void s5_task(const Params& P, LAS unsigned char* lds, int item) {
    const int tid = threadIdx.x, w = tid >> 6, lane = tid & 63, fr = lane & 15, fq = lane >> 4;
    const int pair = item * 4 + (w >> 1), dir = w & 1, b = pair >> 6, g = pair & 63;
    unsigned char* ws = P.ws;
    LAS unsigned char* wl = lds + w * 13824;
    LAS float* BU = (LAS float*)wl;
    LAS unsigned char* X = wl + 8448;
    LAS float* tab = (LAS float*)(wl + 8448 + 4352);
    const int dg = dir * 64 + g;
    float ar, ai;
    { const double lr = (double)P.in[18][dg * 64 + lane], li = (double)P.in[19][dg * 64 + lane], dt = exp((double)P.in[20][dg]);
      const double ea = exp(lr * dt), car = ea * cos(li * dt), cai = ea * sin(li * dt);
      const double den = lr * lr + li * li; const double nr = car - 1.0, ni = cai;
      const double cr = (nr * lr + ni * li) / den, ci = (ni * lr - nr * li) / den;
      ar = (float)car; ai = (float)cai;
      tab[lane * 4 + 0] = ar; tab[lane * 4 + 1] = ai; tab[lane * 4 + 2] = (float)cr; tab[lane * 4 + 3] = (float)ci; }
    asm volatile("s_waitcnt lgkmcnt(0)" ::: "memory");
    bf16x4 Bf[8]; bf16x8 Cf[4]; float Dv[4];
#pragma unroll
    for (int j = 0; j < 8; ++j) { const int col = 16 * j + fr, pp = col >> 1, ri = col & 1; const float cr = tab[pp * 4 + 2], ci = tab[pp * 4 + 3];
        const f32x4 br = *(const f32x4*)(P.in[21] + ((size_t)dg * 64 + pp) * 16 + 4 * fq), bi = *(const f32x4*)(P.in[22] + ((size_t)dg * 64 + pp) * 16 + 4 * fq);
        float v[4];
#pragma unroll
        for (int e = 0; e < 4; ++e) v[e] = ri ? (cr * bi[e] + ci * br[e]) : (cr * br[e] - ci * bi[e]);
        const unsigned w0 = pk_bf16(v[0], v[1]), w1 = pk_bf16(v[2], v[3]);
        Bf[j][0] = (short)(w0 & 0xffff); Bf[j][1] = (short)(w0 >> 16); Bf[j][2] = (short)(w1 & 0xffff); Bf[j][3] = (short)(w1 >> 16); }
#pragma unroll
    for (int kk = 0; kk < 4; ++kk) { const int p0 = 16 * kk + 4 * fq;
        const f32x4 cr = *(const f32x4*)(P.in[23] + ((size_t)dg * 16 + fr) * 64 + p0), ci = *(const f32x4*)(P.in[24] + ((size_t)dg * 16 + fr) * 64 + p0);
#pragma unroll
        for (int e = 0; e < 4; ++e) { const unsigned wv = pk_bf16(cr[e], -ci[e]); Cf[kk][2 * e] = (short)(wv & 0xffff); Cf[kk][2 * e + 1] = (short)(wv >> 16); } }
#pragma unroll
    for (int e = 0; e < 4; ++e) Dv[e] = P.in[25][g * 16 + 4 * fq + e];
    const bf16_t* U = (const bf16_t*)(ws + U_S5) + (size_t)g * NROWS * 16 + 4 * fq;
    float* pbuf = (float*)(ws + PBUF);
    bf16_t* ypre = (bf16_t*)(ws + YPRE);
    f32x2 xs = (f32x2){0.f, 0.f}; const f32x2 arr = (f32x2){ar, ar}, aim = (f32x2){-ai, ai};
#define S5_ROW(c) ((c) < 16 ? (NTOK + b * CTX + (dir ? 255 - (16 * (c) + fr) : (16 * (c) + fr))) : (b * SEQ + (dir ? 2047 - (16 * (c) + fr - 256) : (16 * (c) + fr - 256))))
#define S5_CORE(c) \
        const u32x2 ucur = uq[i & 3]; const int row = S5_ROW(c); \
        { const int cn = ((c) + 4 < 144) ? (c) + 4 : 143; uq[i & 3] = *(const u32x2*)(U + (size_t)S5_ROW(cn) * 16); } \
        { bf16x4 Uf; Uf[0] = (short)(ucur.x & 0xffff); Uf[1] = (short)(ucur.x >> 16); Uf[2] = (short)(ucur.y & 0xffff); Uf[3] = (short)(ucur.y >> 16); \
          _Pragma("unroll") for (int j = 0; j < 8; ++j) { const f32x4 a = __builtin_amdgcn_mfma_f32_16x16x16bf16_1k(Bf[j], Uf, (f32x4){0.f, 0.f, 0.f, 0.f}, 0, 0, 0); \
            *(LAS f32x4*)(BU + fr * 132 + 16 * j + 4 * fq) = a; } } \
        asm volatile("s_waitcnt lgkmcnt(0)" ::: "memory"); \
        { f32x2 bu[16]; \
          _Pragma("unroll") for (int t = 0; t < 16; ++t) bu[t] = *(const LAS f32x2*)(BU + t * 132 + 2 * lane); \
          _Pragma("unroll") for (int t = 0; t < 16; ++t) { const f32x2 tmp = arr * xs + bu[t]; xs = aim * xs.yx + tmp; \
            *(LAS unsigned*)(X + t * 272 + 4 * lane) = pk_bf16(xs.x, xs.y); } } \
        asm volatile("s_waitcnt lgkmcnt(0)" ::: "memory");
#define S5_READOUT() \
        f32x4 y = (f32x4){0.f, 0.f, 0.f, 0.f}; \
        _Pragma("unroll") for (int kk = 0; kk < 4; ++kk) { const bf16x8 xf = *(const LAS bf16x8*)(X + fr * 272 + 64 * kk + 16 * fq); y = __builtin_amdgcn_mfma_f32_16x16x32_bf16(Cf[kk], xf, y, 0, 0, 0); } \
        const size_t oidx = (size_t)row * 1024 + g * 16 + 4 * fq;
    u32x2 uq[4]; f32x4 pq[4];
#pragma unroll
    for (int i = 0; i < 4; ++i) uq[i] = *(const u32x2*)(U + (size_t)S5_ROW(i) * 16);
#pragma unroll 1
    for (int c4 = 0; c4 < 16; c4 += 4) {
#pragma unroll
      for (int i = 0; i < 4; ++i) { const int c = c4 + i; S5_CORE(c) (void)row; }
    }
#pragma unroll 1
    for (int c4 = 16; c4 < 80; c4 += 4) {
#pragma unroll
      for (int i = 0; i < 4; ++i) { const int c = c4 + i; S5_CORE(c) S5_READOUT() *(f32x4*)(pbuf + oidx) = y; }
    }
    __builtin_amdgcn_fence(__ATOMIC_RELEASE, "workgroup"); __syncthreads(); __builtin_amdgcn_fence(__ATOMIC_ACQUIRE, "workgroup");
#pragma unroll
    for (int q = 0; q < 4; ++q) pq[q] = *(const f32x4*)(pbuf + (size_t)S5_ROW(80 + q) * 1024 + g * 16 + 4 * fq);
#pragma unroll 1
    for (int c4 = 80; c4 < 144; c4 += 4) {
#pragma unroll
      for (int i = 0; i < 4; ++i) { const int c = c4 + i; S5_CORE(c) S5_READOUT()
        const f32x4 pv = pq[i];
        { const int cn = (c + 4 < 144) ? c + 4 : 143; pq[i] = *(const f32x4*)(pbuf + (size_t)S5_ROW(cn) * 1024 + g * 16 + 4 * fq); }
        float o[4]; const float uu[4] = {bflo(ucur.x), bfhi(ucur.x), bflo(ucur.y), bfhi(ucur.y)};
#pragma unroll
        for (int e = 0; e < 4; ++e) o[e] = gelu_tanh(y[e] + pv[e] + Dv[e] * uu[e]);
        u32x2 wv; wv.x = pk_bf16(o[0], o[1]); wv.y = pk_bf16(o[2], o[3]);
        *(u32x2*)(ypre + oidx) = wv; }
    }
#undef S5_ROW
#undef S5_CORE
#undef S5_READOUT
}

constexpr int HY_G = 0, HY_GSZ = 8 * 514 * 16, HY_U = HY_GSZ, HY_ROW = 4112, HY_GATE = HY_U + 8 * HY_ROW, HY_H = HY_GATE + 8 * HY_ROW;
static_assert(HY_H + 8192 + 16 <= LDS_BYTES - 64, "hyena LDS");
struct HyRaw { u32x4 v[4]; unsigned nb[4]; };
__device__ __forceinline__ void hy_issue(const Params& P, HyRaw& r, int set, int c) {
    const int tid = threadIdx.x; const int ch = set * 1024 + c;
    const bf16_t* src = (const bf16_t*)(P.ws + PT_HY) + (size_t)ch * NTOK;
#pragma unroll
    for (int q = 0; q < 4; ++q) { const int chunk = tid + NTHR * q; const int b = chunk >> 8, t8 = (chunk & 255) * 8;
        const bf16_t* sp = src + b * SEQ + t8; r.v[q] = *(const u32x4*)sp;
        const unsigned l = (t8 & 63) ? (unsigned)sp[-1] : 0u, rr = ((t8 + 8) & 63) ? (unsigned)sp[8] : 0u; r.nb[q] = l | (rr << 16); }
}
__device__ __forceinline__ void hy_commit(const Params& P, const HyRaw& r, LAS unsigned char* dstbuf, int set, int c) {
    const int tid = threadIdx.x; const int ch = set * 1024 + c;
    const float w0 = P.in[8][0 * 3072 + ch], w1 = P.in[8][1 * 3072 + ch], w2 = P.in[8][2 * 3072 + ch], bias = P.in[9][ch];
#pragma unroll
    for (int q = 0; q < 4; ++q) { const int chunk = tid + NTHR * q; const int b = chunk >> 8, t8 = (chunk & 255) * 8;
        const u32x4 raw = r.v[q];
        float x[10];
        x[1] = bflo(raw.x); x[2] = bfhi(raw.x); x[3] = bflo(raw.y); x[4] = bfhi(raw.y); x[5] = bflo(raw.z); x[6] = bfhi(raw.z); x[7] = bflo(raw.w); x[8] = bfhi(raw.w);
        x[0] = bflo(r.nb[q]); x[9] = bfhi(r.nb[q]);
        float o[8];
#pragma unroll
        for (int j = 0; j < 8; ++j) o[j] = w0 * x[j] + w1 * x[j + 1] + w2 * x[j + 2] + bias;
        u32x4 wv; wv.x = pk_bf16(o[0], o[1]); wv.y = pk_bf16(o[2], o[3]); wv.z = pk_bf16(o[4], o[5]); wv.w = pk_bf16(o[6], o[7]);
        *(LAS u32x4*)(dstbuf + b * HY_ROW + t8 * 2) = wv; }
}
__device__ __forceinline__ u32x4 hy_issue_H(const Params& P, int o, int c) { return ((const u32x4*)((const bf16_t*)(P.ws + HG) + (size_t)(o * 1024 + c) * 4096))[threadIdx.x]; }
__device__ __forceinline__ void hy_commit_H(LAS unsigned char* lds, const u32x4 h) {
    const int tid = threadIdx.x;
    *(LAS u32x4*)(lds + HY_H + 16 * tid) = h;
    if (tid == 0) *(LAS u32x4*)(lds + HY_H + 8192) = (u32x4){0u, 0u, 0u, 0u};
}
__device__ __forceinline__ void hy_build_G(LAS unsigned char* lds) {
    const int q = threadIdx.x;
    const u32x4 A = *(const LAS u32x4*)(lds + HY_H + 16 * (511 - q)), B = *(const LAS u32x4*)(lds + HY_H + 16 * (512 - q));
    const unsigned in[8] = {A.x, A.y, A.z, A.w, B.x, B.y, B.z, B.w};
#pragma unroll
    for (int cc = 0; cc < 8; ++cc) { const int e = 8 - cc; unsigned o4[4];
#pragma unroll
        for (int k = 0; k < 4; ++k) { if ((e & 1) == 0) o4[k] = in[e / 2 + k]; else o4[k] = (in[(e - 1) / 2 + k] >> 16) | (in[(e + 1) / 2 + k] << 16); }
        *(LAS u32x4*)(lds + HY_G + (cc * 514 + q) * 16) = (u32x4){o4[0], o4[1], o4[2], o4[3]}; }
}
__device__ __forceinline__ void hy_mma(LAS unsigned char* lds, f32x4 (&acc)[8]) {
    const int tid = threadIdx.x, w = tid >> 6, lane = tid & 63, fr = lane & 15, fq = lane >> 4, h = fr >> 3;
#pragma unroll
    for (int a = 0; a < 8; ++a) acc[a] = (f32x4){0.f, 0.f, 0.f, 0.f};
    LAS unsigned char* gbase = lds + HY_G + ((fr & 7) * 514 + (fr >> 3) - fq + 256 + 128 + 16 * w) * 16;
    LAS unsigned char* ub = lds + HY_U + (fr & 7) * HY_ROW + 16 * fq;
    const int hoff = h ? 0 : 32;
    const unsigned m_lo = h ? 0xffffffffu : 0u;
    const unsigned m_hi = h ? 0u : 0xffffffffu;
    bf16x8 frag[8];
#pragma unroll
    for (int a = 0; a < 8; ++a) frag[a] = *(const LAS bf16x8*)(gbase + 32 * a);
    u32x4 Bn = *(const LAS u32x4*)(ub + 64 * hoff);
#pragma unroll 1
    for (int K4 = 0; K4 < 24; ++K4) {
        const unsigned msk = (K4 < 8) ? m_lo : ((K4 >= 16) ? m_hi : 0xffffffffu);
#pragma unroll
        for (int kk = 0; kk < 4; ++kk) {
            __builtin_amdgcn_sched_barrier(0);
            const int ks = 4 * K4 + kk;
            u32x4 Bm = Bn; Bm.x &= msk; Bm.y &= msk; Bm.z &= msk; Bm.w &= msk;
            bf16x8 B; __builtin_memcpy(&B, &Bm, 16);
            Bn = *(const LAS u32x4*)(ub + 64 * ((ks + 1 + hoff) & 63));
            __builtin_amdgcn_sched_barrier(0);
#pragma unroll
            for (int a = 7; a >= 0; --a) {
                const int slot = (a - 2 * kk) & 7;
                acc[a] = __builtin_amdgcn_mfma_f32_16x16x32_bf16(frag[slot], B, acc[a], 0, 0, 0);
                if (a >= 6 && ks < 95) frag[slot] = *(const LAS bf16x8*)(gbase + 32 * ((a - 8) - 2 * ks));
            }
        }
    }
}
struct HyPre { HyRaw rv, rx; u32x4 h0; };
__device__ __forceinline__ void hy_prefetch(const Params& P, HyPre& pf, int c) { pf.h0 = hy_issue_H(P, 0, c); hy_issue(P, pf.rv, 0, c); hy_issue(P, pf.rx, 1, c); }
__device__ __forceinline__ int hyena_task(const Params& P, LAS unsigned char* lds, int c, HyPre& pf, int nxt) {
    const int tid = threadIdx.x, w = tid >> 6, lane = tid & 63, fr = lane & 15, fq = lane >> 4;
    hy_commit_H(lds, pf.h0); hy_commit(P, pf.rv, lds + HY_U, 0, c); hy_commit(P, pf.rx, lds + HY_GATE, 1, c);
    __syncthreads();
    hy_build_G(lds);
    __syncthreads();
    HyRaw r2; hy_issue(P, r2, 2, c); const u32x4 h1 = hy_issue_H(P, 1, c);
    f32x4 acc[8];
    hy_mma(lds, acc);
    const float bias0 = P.in[17][c], bias1 = P.in[17][1024 + c];
    u32x2 z1[8];
    const int bb = fr & 7, th = 1024 * (fr >> 3);
#pragma unroll
    for (int a = 0; a < 8; ++a) { const int t = th + 128 * w + 16 * a + 4 * fq;
        const u32x2 gv = *(const LAS u32x2*)(lds + HY_GATE + bb * HY_ROW + 2 * t), vv = *(const LAS u32x2*)(lds + HY_U + bb * HY_ROW + 2 * t);
        const float o0 = bflo(gv.x) * (acc[a][0] + bias0 * bflo(vv.x)), o1 = bfhi(gv.x) * (acc[a][1] + bias0 * bfhi(vv.x));
        const float o2 = bflo(gv.y) * (acc[a][2] + bias0 * bflo(vv.y)), o3 = bfhi(gv.y) * (acc[a][3] + bias0 * bfhi(vv.y));
        z1[a].x = pk_bf16(o0, o1); z1[a].y = pk_bf16(o2, o3); }
    __syncthreads();
#pragma unroll
    for (int a = 0; a < 8; ++a) { const int t = th + 128 * w + 16 * a + 4 * fq; *(LAS u32x2*)(lds + HY_U + bb * HY_ROW + 2 * t) = z1[a]; }
    hy_commit_H(lds, h1);
    hy_commit(P, r2, lds + HY_GATE, 2, c);
    __syncthreads();
    hy_build_G(lds);
    __syncthreads();
    if (nxt < 128 + 1024) hy_prefetch(P, pf, nxt - 128);
    hy_mma(lds, acc);
    bf16_t* yt = (bf16_t*)(P.ws + YT_HY) + (size_t)c * NTOK;
#pragma unroll
    for (int a = 0; a < 8; ++a) { const int t = th + 128 * w + 16 * a + 4 * fq;
        const u32x2 gv = *(const LAS u32x2*)(lds + HY_GATE + bb * HY_ROW + 2 * t); const u32x2 vv = *(const LAS u32x2*)(lds + HY_U + bb * HY_ROW + 2 * t);
        const float o0 = bflo(gv.x) * (acc[a][0] + bias1 * bflo(vv.x)), o1 = bfhi(gv.x) * (acc[a][1] + bias1 * bfhi(vv.x));
        const float o2 = bflo(gv.y) * (acc[a][2] + bias1 * bflo(vv.y)), o3 = bfhi(gv.y) * (acc[a][3] + bias1 * bfhi(vv.y));
        u32x2 wv; wv.x = pk_bf16(o0, o1); wv.y = pk_bf16(o2, o3);
        *(u32x2*)(yt + bb * SEQ + t) = wv; }
    __syncthreads();
    return nxt;
}

__device__ __forceinline__ void phaseD(const Params& P, LAS unsigned char* lds, int rep) {
    LAS int* slot = (LAS int*)(lds + LDS_BYTES - 64);
    unsigned* ctr = (unsigned*)(P.ws + CTR) + rep;
    const int bid = (int)blockIdx.x;
    if ((int)gridDim.x == 256) {
        int c0, n;
        if (bid < 128) { c0 = 2 * bid; n = 2;
#if !defined(NO_S5)
            s5_task(P, lds, bid); __syncthreads();
#endif
        } else { c0 = 256 + 6 * (bid - 128); n = 6; }
#if !defined(NO_HY)
        HyPre pf; hy_prefetch(P, pf, c0);
        for (int i = 0; i < n; ++i) (void)hyena_task(P, lds, c0 + i, pf, (i + 1 < n) ? 128 + c0 + i + 1 : (1 << 20));
#endif
    } else {
#if !defined(NO_S5)
        for (int it = bid; it < 128; it += gridDim.x) { s5_task(P, lds, it); __syncthreads(); }
#endif
#if !defined(NO_HY)
        for (int c = bid; c < 1024; c += gridDim.x) { HyPre pf; hy_prefetch(P, pf, c); (void)hyena_task(P, lds, c, pf, 1 << 20); }
#endif
    }
    (void)slot; (void)ctr;
}

__device__ __forceinline__ void hy_transpose(const Params& P, LAS unsigned char* lds) {
    const int tid = threadIdx.x, w = tid >> 6, lane = tid & 63;
    for (int it = blockIdx.x; it < 256; it += gridDim.x) {
        const int tok0 = it * 64;
        const bf16_t* yt = (const bf16_t*)(P.ws + YT_HY);
        { u32x4 raw[16]; const int tk = lane & 7;
#pragma unroll
          for (int i = 0; i < 16; ++i) { const int c = 8 * (i * 8 + w) + (lane >> 3); raw[i] = *(const u32x4*)(yt + (size_t)c * NTOK + tok0 + 8 * tk); }
#pragma unroll
          for (int i = 0; i < 16; ++i) { const int c = 8 * (i * 8 + w) + (lane >> 3); const unsigned wv[4] = {raw[i].x, raw[i].y, raw[i].z, raw[i].w};
#pragma unroll
            for (int j = 0; j < 8; ++j) { const unsigned short v = (unsigned short)((j & 1) ? (wv[j >> 1] >> 16) : (wv[j >> 1] & 0xffff)); *(LAS unsigned short*)(lds + (8 * tk + j) * 2052 + 2 * c) = v; } } }
        __syncthreads();
        bf16_t* mix = (bf16_t*)(P.ws + ACT_A);
        for (int r = 0; r < 8; ++r) { const int tok = 8 * w + r; unsigned wv[8]; float ss = 0.f;
#pragma unroll
            for (int j = 0; j < 8; ++j) { wv[j] = *(const LAS unsigned*)(lds + tok * 2052 + 32 * lane + 4 * j); const float a = bflo(wv[j]), b2 = bfhi(wv[j]); ss += a * a + b2 * b2; }
            ss = wave_sum(ss); const float rs = rsqrtf(ss * (1.0f / 1024.0f) + 1e-6f);
            const float* gp = P.in[29] + 16 * lane; unsigned ov[8];
#pragma unroll
            for (int j = 0; j < 8; ++j) ov[j] = pk_bf16(bflo(wv[j]) * rs * gp[2 * j], bfhi(wv[j]) * rs * gp[2 * j + 1]);
            bf16_t* op = mix + (size_t)(tok0 + tok) * DM + 1024 + 16 * lane;
            *(u32x4*)op = (u32x4){ov[0], ov[1], ov[2], ov[3]}; *(u32x4*)(op + 8) = (u32x4){ov[4], ov[5], ov[6], ov[7]}; }
        __syncthreads();
    }
}
__device__ __forceinline__ void s5_norm(const Params& P) {
    const int tid = threadIdx.x, w = tid >> 6, lane = tid & 63;
    bf16_t* mix = (bf16_t*)(P.ws + ACT_A);
    const float* gp = P.in[28] + 16 * lane;
    for (int row0 = (blockIdx.x * 8 + w) * 4; row0 < NTOK; row0 += gridDim.x * 32) {
        u32x4 r0[4], r1[4];
#pragma unroll
        for (int u = 0; u < 4; ++u) { const bf16_t* rp = mix + (size_t)(row0 + u) * DM + 16 * lane; r0[u] = *(const u32x4*)rp; r1[u] = *(const u32x4*)(rp + 8); }
#pragma unroll
        for (int u = 0; u < 4; ++u) { bf16_t* rp = mix + (size_t)(row0 + u) * DM + 16 * lane;
            const unsigned wv[8] = {r0[u].x, r0[u].y, r0[u].z, r0[u].w, r1[u].x, r1[u].y, r1[u].z, r1[u].w}; float ss = 0.f;
#pragma unroll
            for (int j = 0; j < 8; ++j) { const float a = bflo(wv[j]), b2 = bfhi(wv[j]); ss += a * a + b2 * b2; }
            ss = wave_sum(ss); const float rs = rsqrtf(ss * (1.0f / 1024.0f) + 1e-6f);
            unsigned ov[8];
#pragma unroll
            for (int j = 0; j < 8; ++j) ov[j] = pk_bf16(bflo(wv[j]) * rs * gp[2 * j], bfhi(wv[j]) * rs * gp[2 * j + 1]);
            *(u32x4*)rp = (u32x4){ov[0], ov[1], ov[2], ov[3]}; *(u32x4*)(rp + 8) = (u32x4){ov[4], ov[5], ov[6], ov[7]}; }
    }
}
template <int MODE> __device__ __forceinline__ void row_norm(const Params& P) {
    const int tid = threadIdx.x, w = tid >> 6, lane = tid & 63;
    const float* modf = (const float*)(P.ws + MODF);
    bf16_t* h2 = (bf16_t*)(P.ws + ACT_A);
    constexpr int NR = 4;
    for (int row0 = (blockIdx.x * 8 + w) * NR; row0 < NTOK; row0 += gridDim.x * 8 * NR) {
        u32x2 raw[NR][8];
#pragma unroll
        for (int u = 0; u < NR; ++u) { const bf16_t* xb = (const bf16_t*)(P.ws + PBUF) + (size_t)(row0 + u) * DM;
#pragma unroll
            for (int q = 0; q < 8; ++q) raw[u][q] = *(const u32x2*)(xb + 4 * (lane + 64 * q)); }
#pragma unroll
        for (int u = 0; u < NR; ++u) { const int row = row0 + u; float* xr = P.out + (size_t)row * DM; const int b = row >> 11;
            f32x4 v[8]; float ss = 0.f;
#pragma unroll
            for (int q = 0; q < 8; ++q) { const u32x2 rb = raw[u][q]; v[q] = (f32x4){bflo(rb.x), bfhi(rb.x), bflo(rb.y), bfhi(rb.y)}; ss += v[q][0] * v[q][0] + v[q][1] * v[q][1] + v[q][2] * v[q][2] + v[q][3] * v[q][3]; }
            ss = wave_sum(ss); const float r = rsqrtf(ss * (1.0f / DM) + 1e-6f);
#pragma unroll
            for (int q = 0; q < 8; ++q) { const int c0 = 4 * (lane + 64 * q);
                if (MODE == 0) { const f32x4 g = *(const f32x4*)(P.in[31] + c0); const f32x4 sh = *(const f32x4*)(modf + (size_t)b * 12288 + 3 * 2048 + c0), sc = *(const f32x4*)(modf + (size_t)b * 12288 + 4 * 2048 + c0);
                    float o[4];
#pragma unroll
                    for (int e = 0; e < 4; ++e) o[e] = (v[q][e] * r * g[e]) * (1.0f + sc[e]) + sh[e];
                    u32x2 wv; wv.x = pk_bf16(o[0], o[1]); wv.y = pk_bf16(o[2], o[3]); *(u32x2*)(h2 + (size_t)row * DM + c0) = wv; }
                else { const f32x4 g = *(const f32x4*)(P.in[35] + c0); __builtin_nontemporal_store(v[q] * r * g, (f32x4*)(xr + c0)); } } }
    }
}

__global__ void __launch_bounds__(NTHR, 2) mega(Params P) {
    extern __shared__ __attribute__((aligned(16))) unsigned char lds_raw[];
    LAS unsigned char* lds = (LAS unsigned char*)lds_raw;
    cg::grid_group grid = cg::this_grid();
    unsigned char* ws = P.ws;
    const int lo = P.ph_lo, hi = P.ph_hi, G = gridDim.x, bid = blockIdx.x;
#ifndef PHMASK
#define PHMASK 0x7ff
#endif
#define IN(k) (((PHMASK >> (k)) & 1) && lo <= (k) && (k) < hi)
    { volatile LAS unsigned* stw = (volatile LAS unsigned*)(lds + LDS_BYTES - 32); if (threadIdx.x < 4) stw[threadIdx.x] = 0u; }
    __syncthreads();
    XcdBarrier xbar = xcd_barrier_post((unsigned*)(ws + WS_BAR), (volatile LAS unsigned*)(lds + LDS_BYTES - 32));
    if (P.ph_hi > 1000) grid.sync();
#define SEAM(k) do { if (IN(k) && IN((k) + 1)) xcd_barrier(xbar); } while (0)
#ifndef DUPMASK
#define DUPMASK 0
#endif
#define DUP(k) ((DUPMASK >> (k)) & 1)
    if (IN(0)) { phaseA(P, lds_raw); if (DUP(0)) { __syncthreads(); phaseA(P, lds_raw); } }
    SEAM(0);
    if (IN(1)) { phaseB(P, lds_raw, lds); if (DUP(1)) { __syncthreads(); phaseB(P, lds_raw, lds); } }
    SEAM(1);
    if (IN(2)) { pg8::Gemm g{(const bf16_t*)(ws + ACT_A), (const bf16_t*)(ws + WB_IN), NTOK, 4096, 2048}; pg8::StaticOrder S; S.init(NTOK, 4096, G, bid, (G >= 64) ? 0 : 32);
        pg8::EpiInProj E{(bf16_t*)(ws + U_S5), (bf16_t*)(ws + PT_HY)}; pg8::gemm_phase(lds, g, S, E); }
    SEAM(2);
    if (IN(3)) { phaseD(P, lds, 0); if (DUP(3)) { __syncthreads(); phaseD(P, lds, 1); } }
    SEAM(3);
    if (IN(4)) { pg8::Gemm g{(const bf16_t*)(ws + YPRE), (const bf16_t*)(ws + WB_GLU), NTOK, 2048, 1024}; pg8::StaticOrder S; S.init(NTOK, 2048, G, bid, 0);
        pg8::EpiGate<0> E{(bf16_t*)(ws + ACT_A), DM, P.in[27], 1024}; pg8::gemm_phase(lds, g, S, E);
        hy_transpose(P, lds); }
    SEAM(4);
    if (IN(5)) s5_norm(P);
    SEAM(5);
    if (IN(6)) { pg8::Gemm g{(const bf16_t*)(ws + ACT_A), (const bf16_t*)(ws + WB_OUT), NTOK, 2048, 2048}; pg8::StaticOrder S; S.init(NTOK, 2048, G, bid, 0);
        pg8::EpiRes<false> E{P.in[0], (bf16_t*)(ws + PBUF), (const float*)(ws + MODF) + 2 * 2048}; pg8::gemm_phase(lds, g, S, E); }
    SEAM(6);
    if (IN(7)) row_norm<0>(P);
    SEAM(7);
    if (IN(8)) { pg8::Gemm g{(const bf16_t*)(ws + ACT_A), (const bf16_t*)(ws + WB_GU), NTOK, 11264, 2048}; pg8::StaticOrder S; S.init(NTOK, 11264, G, bid, 0);
        pg8::EpiGate<1> E{(bf16_t*)(ws + HID), DFF, nullptr, 0}; pg8::gemm_phase(lds, g, S, E); }
    SEAM(8);
    if (IN(9)) { pg8::Gemm g{(const bf16_t*)(ws + HID), (const bf16_t*)(ws + WB_DN), NTOK, 2048, DFF}; pg8::StaticOrder S; S.init(NTOK, 2048, G, bid, 0);
        pg8::EpiRes<true> E{(const void*)(ws + PBUF), (bf16_t*)(ws + PBUF), (const float*)(ws + MODF) + 5 * 2048}; pg8::gemm_phase(lds, g, S, E); }
    SEAM(9);
    if (IN(10)) row_norm<1>(P);
}

extern "C" void kernel_launch(void* const* d_in, const int* in_sizes, int n_in, void* d_out, int out_size, void* d_ws, size_t ws_size, hipStream_t stream) {
    static int grid_blocks = 0;
    if (!grid_blocks) {
        int dev = 0, cus = 0, per_cu = 0;
        hipGetDevice(&dev);
        hipDeviceGetAttribute(&cus, hipDeviceAttributeMultiprocessorCount, dev);
        if (hipFuncSetAttribute((const void*)mega, hipFuncAttributeMaxDynamicSharedMemorySize, LDS_BYTES) != hipSuccess) fprintf(stderr, "hipFuncSetAttribute failed\n");
        hipOccupancyMaxActiveBlocksPerMultiprocessor(&per_cu, (const void*)mega, NTHR, LDS_BYTES);
        if (per_cu < 1) { fprintf(stderr, "occupancy query says %d\n", per_cu); per_cu = 1; }
        (void)hipGetLastError();
        grid_blocks = cus * per_cu;
        if (ws_size < WS_END) fprintf(stderr, "workspace too small: %zu < %zu\n", ws_size, (size_t)WS_END);
        if (n_in != 36) fprintf(stderr, "unexpected n_in %d\n", n_in);
    }
    Params p{};
    for (int i = 0; i < 36; ++i) p.in[i] = (const float*)d_in[i];
    p.out = (float*)d_out; p.ws = (unsigned char*)d_ws;
#if ONE_LAUNCH
    (void)hipMemsetAsync((unsigned char*)d_ws + WS_BAR, 0, (size_t)XCD_BAR_WORDS * 4, stream);
    p.ph_lo = 0; p.ph_hi = NPHASE;
    void* args[] = {&p};
    hipError_t e = hipLaunchCooperativeKernel((const void*)mega, dim3(grid_blocks), dim3(NTHR), args, LDS_BYTES, stream);
    if (e != hipSuccess) fprintf(stderr, "cooperative launch failed: %s (grid %d)\n", hipGetErrorString(e), grid_blocks);
#else
    for (int ph = 0; ph < NPHASE; ++ph) { p.ph_lo = ph; p.ph_hi = ph + 1; hipLaunchKernelGGL(mega, dim3(grid_blocks), dim3(NTHR), LDS_BYTES, stream, p); }
#endif
}
```

```cpp
#include <hip/hip_runtime.h>
#include <hip/hip_cooperative_groups.h>
#include <cstdio>
namespace cg = cooperative_groups;

#ifndef ONE_LAUNCH
#define ONE_LAUNCH 1
#endif

#define LAS __attribute__((address_space(3)))
typedef unsigned short bf16_t;
typedef short bf16x8 __attribute__((ext_vector_type(8)));
typedef short bf16x4 __attribute__((ext_vector_type(4)));
typedef float f32x4 __attribute__((ext_vector_type(4)));
typedef float f32x2 __attribute__((ext_vector_type(2)));
typedef unsigned u32x4 __attribute__((ext_vector_type(4)));
typedef unsigned u32x2 __attribute__((ext_vector_type(2)));

constexpr int NTHR = 512;
constexpr int LDS_BYTES = 147456;
constexpr int NPHASE = 11;

constexpr int DM = 2048, NB = 8, SEQ = 2048, CTX = 256, NTOK = NB * SEQ, NCTX = NB * CTX, NROWS = NTOK + NCTX;
constexpr int DFF = 5632;

constexpr size_t WB_IN = 0;
constexpr size_t WB_GLU = WB_IN + (size_t)4096 * 2048 * 2;
constexpr size_t WB_OUT = WB_GLU + (size_t)2048 * 1024 * 2;
constexpr size_t WB_GU = WB_OUT + (size_t)2048 * 2048 * 2;
constexpr size_t WB_DN = WB_GU + (size_t)11264 * 2048 * 2;
constexpr size_t ACT_A = WB_DN + (size_t)2048 * 5632 * 2;
constexpr size_t U_S5 = ACT_A + (size_t)NROWS * 2048 * 2;
constexpr size_t PT_HY = U_S5 + (size_t)64 * NROWS * 16 * 2;
constexpr size_t YT_HY = PT_HY + (size_t)3072 * NTOK * 2;
constexpr size_t YPRE = YT_HY + (size_t)1024 * NTOK * 2;
constexpr size_t HID = U_S5;
constexpr size_t PBUF = YPRE + (size_t)NTOK * 1024 * 2;
constexpr size_t HG = PBUF + (size_t)NTOK * 1024 * 4;
constexpr size_t MODP = HG + (size_t)2 * 1024 * 4096 * 2;
constexpr size_t MODF = MODP + (size_t)8 * 9 * 12288 * 4;
constexpr size_t H2F = MODF + (size_t)9 * 12288 * 4;
constexpr size_t CTR = H2F + (size_t)2048 * 64 * 4;
constexpr size_t WS_BAR = CTR + 256;
constexpr int XCD_BAR_WORDS = 3456;
constexpr size_t WS_END = WS_BAR + (size_t)XCD_BAR_WORDS * 4;
static_assert(HID + (size_t)NTOK * DFF * 2 <= PBUF, "hidden alias");

struct Params { const float* in[36]; float* out; unsigned char* ws; int ph_lo, ph_hi; };

typedef __bf16 bf16v2_t __attribute__((ext_vector_type(2)));
__device__ __forceinline__ unsigned pk_bf16(float lo, float hi) { const f32x2 v = (f32x2){lo, hi}; const bf16v2_t b = __builtin_convertvector(v, bf16v2_t); unsigned r; __builtin_memcpy(&r, &b, 4); return r; }
__device__ __forceinline__ bf16_t f2bf(float f) { return (bf16_t)(pk_bf16(f, 0.f) & 0xffffu); }
__device__ __forceinline__ float bf2f(unsigned b) { return __uint_as_float(b << 16); }
__device__ __forceinline__ float bflo(unsigned w) { return __uint_as_float(w << 16); }
__device__ __forceinline__ float bfhi(unsigned w) { return __uint_as_float(w & 0xffff0000u); }
__device__ __forceinline__ float wave_sum(float v) { for (int o = 32; o; o >>= 1) v += __shfl_xor(v, o); return v; }
__device__ __forceinline__ float sigmoidf_(float x) { return __builtin_amdgcn_rcpf(1.0f + __builtin_amdgcn_exp2f(-1.4426950408889634f * x)); }
__device__ __forceinline__ float gelu_tanh(float x) { const float u = 0.7978845608028654f * (x + 0.044715f * x * x * x); const float e = __builtin_amdgcn_exp2f(2.8853900817779268f * u); return x * (1.0f - __builtin_amdgcn_rcpf(1.0f + e)); }

namespace pg8 {
constexpr int BM = 256, BK = 64, HALF = 128, HTB = HALF * BK * 2, STAGE_BYTES = 8 * HTB, NXCD = 8, WGM = 8;
__device__ __forceinline__ int lds_byte(int r, int c) { const int st = (r >> 4) * 2 + (c >> 5), rr = r & 15, cc = c & 31, ob = rr * 64 + cc * 2; return st * 1024 + (ob ^ (((ob >> 9) & 1) << 5)); }
__device__ __forceinline__ void stage_rc(int b, int& R, int& C) { const int st = b / 1024, sb = b % 1024, swz = sb ^ (((sb >> 9) & 1) << 5); R = (st >> 1) * 16 + swz / 64; C = (st & 1) * 32 + (swz % 64) / 2; }
__device__ __forceinline__ int perm32(int rho) { const int n = rho >> 4, i = rho & 15; return 8 * (i >> 2) + 4 * n + (i & 3); }
struct Unit { int pm, pn; };
struct Gemm { const bf16_t* A; const bf16_t* Bt; int M, N, K; };

struct StaticOrder {
    int nM, nN, nwg, G, c, extra;
    __device__ void init(int M, int N, int G_, int c_, int extra_) { nM = M / BM; nN = N / BM; nwg = nM * nN; G = G_; c = c_; extra = extra_; }
    __device__ bool next(int i, Unit& u) const {
        const long L = (long)i * G + c;
        if (L >= nwg) { const int j = (int)(L - nwg); if (j >= extra) return false; u.pm = nM + (j & 7); u.pn = j >> 3; return true; }
        int wgid = (int)L; { const int q = nwg / NXCD, r = nwg % NXCD, xcd = wgid % NXCD, off = wgid / NXCD; wgid = (xcd < r ? xcd * (q + 1) : r * (q + 1) + (xcd - r) * q) + off; }
        const int nig = WGM * nN, gid = wgid / nig, fm = gid * WGM, gsz = (nM - fm) < WGM ? (nM - fm) : WGM;
        u.pm = fm + ((wgid % nig) % gsz); u.pn = (wgid % nig) / gsz; return true;
    }
};

template <class Epi>
__device__ __forceinline__ void gemm_phase(LAS unsigned char* lds, const Gemm g, const StaticOrder& S, const Epi& E) {
    const int tid = threadIdx.x, wid = __builtin_amdgcn_readfirstlane(tid >> 6), lane = tid & 63, wr = wid >> 2, wc = wid & 3, fr = lane & 15, fq = lane >> 4;
    const int K = g.K, nt = K / BK;
    unsigned voffA[2], voffB[2];
#pragma unroll
    for (int i = 0; i < 2; ++i) { int R, C; stage_rc(tid * 16 + i * 8192, R, C); const int Rb = Epi::PERM ? ((R & ~31) + perm32(R & 31)) : R;
        voffA[i] = (unsigned)(R * K + C) * 2u; voffB[i] = (unsigned)(Rb * K + C) * 2u; }
    const size_t kstep = (size_t)(BK * 2);
    const size_t hstep = (size_t)HALF * K * 2;
    const size_t tstep = 2 * hstep;
    const unsigned ldsw = (unsigned)wid * 1024u;
    const int aoff = lds_byte(wr * 64 + fr, fq * 8), boff = lds_byte(wc * 32 + fr, fq * 8);
#define PG8_SA(b, h) (((b) * 2 + (h)) * HTB)
#define PG8_SB(b, h) ((4 + (b) * 2 + (h)) * HTB)
#define PG8_STAGE(bufoff, gbase, voff) do { _Pragma("unroll") for (int _i = 0; _i < 2; ++_i) \
        __builtin_amdgcn_global_load_lds((const unsigned*)((const char*)(gbase) + (voff)[_i]), (LAS unsigned*)(lds + (bufoff) + ldsw + _i * 8192), 16, 0, 0); } while (0)
#define PG8_LDA(dst, b, h) do { _Pragma("unroll") for (int m = 0; m < 4; ++m) _Pragma("unroll") for (int k = 0; k < 2; ++k) dst[m][k] = *(const LAS bf16x8*)(lds + PG8_SA(b, h) + aoff + m * 2048 + k * 1024); } while (0)
#define PG8_LDB(dst, b, h) do { _Pragma("unroll") for (int n = 0; n < 2; ++n) _Pragma("unroll") for (int k = 0; k < 2; ++k) dst[n][k] = *(const LAS bf16x8*)(lds + PG8_SB(b, h) + boff + n * 2048 + k * 1024); } while (0)
#define PG8_MMA(ai, bj, At, Bt) do { __builtin_amdgcn_s_setprio(1); _Pragma("unroll") for (int m = 0; m < 4; ++m) _Pragma("unroll") for (int n = 0; n < 2; ++n) _Pragma("unroll") for (int k = 0; k < 2; ++k) \
        acc[ai][bj][m][n] = __builtin_amdgcn_mfma_f32_16x16x32_bf16(Bt[n][k], At[m][k], acc[ai][bj][m][n], 0, 0, 0); __builtin_amdgcn_s_setprio(0); } while (0)
#define PG8_WAIT_V(n) asm volatile("s_waitcnt vmcnt(" #n ")" ::: "memory")
#define PG8_WAIT_L(n) asm volatile("s_waitcnt lgkmcnt(" #n ")" ::: "memory")
#define PG8_BAR __builtin_amdgcn_s_barrier()
#define PG8_SCHED __builtin_amdgcn_sched_barrier(0)
    Unit cur, nxt; int ui = 0;
    if (!S.next(0, cur)) return;
    f32x4 acc[2][2][4][2];
#pragma unroll
    for (int a = 0; a < 2; ++a)
#pragma unroll
        for (int b = 0; b < 2; ++b)
#pragma unroll
            for (int m = 0; m < 4; ++m)
#pragma unroll
                for (int n = 0; n < 2; ++n) acc[a][b][m][n] = (f32x4){0.f, 0.f, 0.f, 0.f};
    bf16x8 At[4][2], B0[2][2], B1[2][2];
    const char* cA = (const char*)g.A + (size_t)cur.pm * tstep; const char* cB = (const char*)g.Bt + (size_t)cur.pn * tstep;
    PG8_STAGE(PG8_SB(0, 0), cB, voffB); PG8_STAGE(PG8_SA(0, 0), cA, voffA); PG8_STAGE(PG8_SB(0, 1), cB + hstep, voffB); PG8_STAGE(PG8_SA(0, 1), cA + hstep, voffA);
    if (wr == 1) PG8_BAR;
    PG8_WAIT_V(4); PG8_BAR;
    PG8_STAGE(PG8_SB(1, 0), cB + kstep, voffB); PG8_STAGE(PG8_SA(1, 0), cA + kstep, voffA); PG8_STAGE(PG8_SB(1, 1), cB + hstep + kstep, voffB);
    PG8_WAIT_V(6); PG8_BAR;
    for (;;) {
        const bool has_next = S.next(ui + 1, nxt);
        const char* nA = has_next ? (const char*)g.A + (size_t)nxt.pm * tstep : cA; const char* nB = has_next ? (const char*)g.Bt + (size_t)nxt.pn * tstep : cB;
        for (int t = 0; t < nt; t += 2) {
            const bool last = (t == nt - 2);
            const char* a1 = cA + (size_t)(t + 1) * kstep;
            const char* a2 = last ? nA : cA + (size_t)(t + 2) * kstep; const char* b2 = last ? nB : cB + (size_t)(t + 2) * kstep;
            const char* a3 = a2 + kstep; const char* b3 = b2 + kstep;
            PG8_LDB(B0, 0, 0); PG8_SCHED; PG8_LDA(At, 0, 0); PG8_STAGE(PG8_SA(1, 1), a1 + hstep, voffA);
            PG8_WAIT_L(8); PG8_BAR; PG8_WAIT_L(0); PG8_MMA(0, 0, At, B0); PG8_BAR; PG8_SCHED;
            PG8_LDB(B1, 0, 1); PG8_STAGE(PG8_SB(0, 0), b2, voffB);
            PG8_BAR; PG8_WAIT_L(0); PG8_MMA(0, 1, At, B1); PG8_BAR;
            PG8_LDA(At, 0, 1); PG8_STAGE(PG8_SA(0, 0), a2, voffA);
            PG8_BAR; PG8_WAIT_L(0); PG8_MMA(1, 0, At, B0); PG8_BAR; PG8_SCHED;
            PG8_STAGE(PG8_SB(0, 1), b2 + hstep, voffB);
            PG8_WAIT_V(6); PG8_BAR; PG8_MMA(1, 1, At, B1); PG8_BAR;
            PG8_LDB(B0, 1, 0); PG8_SCHED; PG8_LDA(At, 1, 0); PG8_STAGE(PG8_SA(0, 1), a2 + hstep, voffA);
            PG8_WAIT_L(8); PG8_BAR; PG8_WAIT_L(0); PG8_MMA(0, 0, At, B0); PG8_BAR; PG8_SCHED;
            PG8_LDB(B1, 1, 1); PG8_STAGE(PG8_SB(1, 0), b3, voffB);
            PG8_BAR; PG8_WAIT_L(0); PG8_MMA(0, 1, At, B1); PG8_BAR;
            PG8_LDA(At, 1, 1); PG8_STAGE(PG8_SA(1, 0), a3, voffA);
            PG8_BAR; PG8_WAIT_L(0); PG8_MMA(1, 0, At, B0); PG8_BAR; PG8_SCHED;
            PG8_STAGE(PG8_SB(1, 1), b3 + hstep, voffB);
            PG8_WAIT_V(6); PG8_BAR; PG8_MMA(1, 1, At, B1); PG8_BAR;
        }
        E(acc, cur, wr, wc, fr, fq);
        if (!has_next) break;
#pragma unroll
        for (int a = 0; a < 2; ++a)
#pragma unroll
            for (int b = 0; b < 2; ++b)
#pragma unroll
                for (int m = 0; m < 4; ++m)
#pragma unroll
                    for (int n = 0; n < 2; ++n) acc[a][b][m][n] = (f32x4){0.f, 0.f, 0.f, 0.f};
        cur = nxt; cA = nA; cB = nB; ++ui;
    }
    PG8_WAIT_V(0);
    if (wr == 0) PG8_BAR;
    PG8_BAR;
#undef PG8_SA
#undef PG8_SB
#undef PG8_STAGE
#undef PG8_LDA
#undef PG8_LDB
#undef PG8_MMA
#undef PG8_WAIT_V
#undef PG8_WAIT_L
#undef PG8_BAR
#undef PG8_SCHED
}

struct EpiInProj {
    static constexpr bool PERM = true;
    bf16_t* U; bf16_t* PT;
    __device__ __forceinline__ void operator()(const f32x4 (&acc)[2][2][4][2], const Unit& u, int wr, int wc, int fr, int fq) const {
        const int row0 = u.pm * BM + wr * 64 + fr, colb = u.pn * BM + wc * 32 + 8 * fq;
#pragma unroll
        for (int ai = 0; ai < 2; ++ai)
#pragma unroll
            for (int m = 0; m < 4; ++m) { const int row = row0 + ai * HALF + m * 16;
#pragma unroll
                for (int bj = 0; bj < 2; ++bj) { const int col = colb + bj * HALF; const f32x4 v0 = acc[ai][bj][m][0], v1 = acc[ai][bj][m][1];
                    if (u.pn < 4) { u32x4 w; w.x = pk_bf16(v0[0], v0[1]); w.y = pk_bf16(v0[2], v0[3]); w.z = pk_bf16(v1[0], v1[1]); w.w = pk_bf16(v1[2], v1[3]);
                        *(u32x4*)(U + ((size_t)(col >> 4) * NROWS + row) * 16 + (col & 15)) = w; }
                    else { bf16_t* p = PT + (size_t)(col - 1024) * NTOK + row;
#pragma unroll
                        for (int j = 0; j < 4; ++j) { p[(size_t)j * NTOK] = f2bf(v0[j]); p[(size_t)(4 + j) * NTOK] = f2bf(v1[j]); } } } }
    }
};
template <int KIND  > struct EpiGate {
    static constexpr bool PERM = true;
    bf16_t* O; int ldo; const float* bias; int boff;
    __device__ __forceinline__ void operator()(const f32x4 (&acc)[2][2][4][2], const Unit& u, int wr, int wc, int fr, int fq) const {
        const int row0 = u.pm * BM + wr * 64 + fr, col0 = u.pn * HALF + wc * 32 + 8 * fq;
        f32x4 ba[2], bb[2];
#pragma unroll
        for (int n = 0; n < 2; ++n) { if (KIND == 0) { ba[n] = *(const f32x4*)(bias + col0 + 4 * n); bb[n] = *(const f32x4*)(bias + boff + col0 + 4 * n); } else { ba[n] = (f32x4){0.f, 0.f, 0.f, 0.f}; bb[n] = ba[n]; } }
#pragma unroll
        for (int ai = 0; ai < 2; ++ai)
#pragma unroll
            for (int m = 0; m < 4; ++m) { const int row = row0 + ai * HALF + m * 16; float o[8];
#pragma unroll
                for (int n = 0; n < 2; ++n)
#pragma unroll
                    for (int j = 0; j < 4; ++j) { const float a = acc[ai][0][m][n][j] + ba[n][j], b = acc[ai][1][m][n][j] + bb[n][j];
                        o[4 * n + j] = (KIND == 0) ? a * sigmoidf_(b) : (a * sigmoidf_(a)) * b; }
                u32x4 w; w.x = pk_bf16(o[0], o[1]); w.y = pk_bf16(o[2], o[3]); w.z = pk_bf16(o[4], o[5]); w.w = pk_bf16(o[6], o[7]);
                *(u32x4*)(O + (size_t)row * ldo + col0) = w; }
    }
};
template <bool RES_BF16> struct EpiRes {
    static constexpr bool PERM = false;
    const void* res; bf16_t* out; const float* gate;
    __device__ __forceinline__ void operator()(const f32x4 (&acc)[2][2][4][2], const Unit& u, int wr, int wc, int fr, int fq) const {
        const int row0 = u.pm * BM + wr * 64 + fr, col0 = u.pn * BM + wc * 32 + 4 * fq;
        const float* gp = gate + (size_t)(u.pm >> 3) * 12288 + col0;
        f32x4 gv[2][2];
#pragma unroll
        for (int bj = 0; bj < 2; ++bj)
#pragma unroll
            for (int n = 0; n < 2; ++n) gv[bj][n] = *(const f32x4*)(gp + bj * HALF + n * 16);
#pragma unroll
        for (int ai = 0; ai < 2; ++ai)
#pragma unroll
            for (int m = 0; m < 4; ++m) { const size_t ro = (size_t)(row0 + ai * HALF + m * 16) * DM + col0;
#pragma unroll
                for (int bj = 0; bj < 2; ++bj)
#pragma unroll
                    for (int n = 0; n < 2; ++n) { const size_t o = ro + bj * HALF + n * 16; f32x4 r;
                        if (RES_BF16) { const u32x2 rb = *(const u32x2*)((const bf16_t*)res + o); r = (f32x4){bflo(rb.x), bfhi(rb.x), bflo(rb.y), bfhi(rb.y)}; }
                        else r = *(const f32x4*)((const float*)res + o);
                        const f32x4 v = r + gv[bj][n] * acc[ai][bj][m][n];
                        u32x2 wv; wv.x = pk_bf16(v[0], v[1]); wv.y = pk_bf16(v[2], v[3]); *(u32x2*)(out + o) = wv; } }
    }
};
}

#define XB_TMO      128
#define XB_XCNT(j)  (256  + 64 * (j))
#define XB_XSUB(j)  (1280 + 64 * (j))
#define XB_XGEN(j)  (2304 + 64 * (j))
#define XB_TOP      3328
#define XB_TOPGEN   3392
#define XB_SPIN_CAP (1u << 22)
__device__ __forceinline__ unsigned xb_ld(unsigned* p)              { return __hip_atomic_load(p, __ATOMIC_RELAXED, __HIP_MEMORY_SCOPE_AGENT); }
__device__ __forceinline__ unsigned xb_add(unsigned* p, unsigned v) { return __hip_atomic_fetch_add(p, v, __ATOMIC_RELAXED, __HIP_MEMORY_SCOPE_AGENT); }
__device__ __forceinline__ unsigned xb_xcc_id() { return (unsigned)__builtin_amdgcn_s_getreg((3 << 11) | 20) & 0xFu; }
#define XB_SPIN(cond, bar) do { unsigned _sp = 0; while (cond) { __builtin_amdgcn_s_sleep(1); \
    if ((++_sp & 255u) == 0u) { if (xb_ld(&(bar)[XB_TMO])) break; if (_sp > XB_SPIN_CAP) { atomicAdd(&(bar)[XB_TMO], 1u); break; } } } } while (0)
struct XcdBarrier { unsigned* bar; unsigned x; volatile LAS unsigned* st; };
__device__ __forceinline__ XcdBarrier xcd_barrier_post(unsigned* bar, volatile LAS unsigned* st) {
    XcdBarrier b; b.bar = bar; b.x = xb_xcc_id(); b.st = st;
    if (threadIdx.x == 0) (void)xb_add(&bar[XB_XCNT(b.x)], 1u);
    return b;
}
__device__ __forceinline__ void xcd_barrier_complete(unsigned* bar, unsigned x, unsigned& nloc, unsigned& nx) {
    const unsigned G = gridDim.x * gridDim.y * gridDim.z;
    unsigned sum, cnt, mine, sp = 0u;
    for (;;) {
        sum = 0u; cnt = 0u; mine = 0u;
#pragma unroll
        for (unsigned j = 0; j < 16; ++j) { const unsigned c = xb_ld(&bar[XB_XCNT(j)]); sum += c; cnt += (c > 0u) ? 1u : 0u; mine = (j == x) ? c : mine; }
        if (sum == G) break;
        __builtin_amdgcn_s_sleep(1);
        if ((++sp & 255u) == 0u) { if (xb_ld(&bar[XB_TMO])) break; if (sp > XB_SPIN_CAP) { atomicAdd(&bar[XB_TMO], 1u); break; } }
    }
    nloc = mine > 0u ? mine : 1u; nx = cnt > 0u ? cnt : 1u;
}
__device__ __forceinline__ void xcd_barrier(const XcdBarrier& b) {
    asm volatile("s_waitcnt vmcnt(0)" ::: "memory");
    __syncthreads();
    if (threadIdx.x == 0) {
        unsigned* bar = b.bar;
        __builtin_amdgcn_s_waitcnt(0);
        unsigned nloc = b.st[0], nx = b.st[1];
        if (nloc == 0u) { xcd_barrier_complete(bar, b.x, nloc, nx); b.st[0] = nloc; b.st[1] = nx; }
        const unsigned old = xb_add(&bar[XB_XSUB(b.x)], 1u);
        const unsigned gen = old / nloc;
        if (old + 1u == (gen + 1u) * nloc) {
            __builtin_amdgcn_fence(__ATOMIC_RELEASE, "agent");
            asm volatile("s_waitcnt vmcnt(0)" ::: "memory");
            const unsigned og = xb_add(&bar[XB_TOP], 1u);
            const unsigned tg = og / nx;
            if (og + 1u == (tg + 1u) * nx) xb_add(&bar[XB_TOPGEN], 1u);
            else XB_SPIN(xb_ld(&bar[XB_TOPGEN]) == tg, bar);
            __builtin_amdgcn_fence(__ATOMIC_ACQUIRE, "agent");
            xb_add(&bar[XB_XGEN(b.x)], 1u);
            asm volatile("s_waitcnt vmcnt(0)" ::: "memory");
        } else {
            XB_SPIN(xb_ld(&bar[XB_XGEN(b.x)]) == gen, bar);
            __builtin_amdgcn_fence(__ATOMIC_ACQUIRE, "agent");
            asm volatile("s_waitcnt vmcnt(0)" ::: "memory");
        }
    }
    __syncthreads();
}

__device__ __forceinline__ void convert_items(const Params& P, int Tb, int Te, int worker, int nworkers) {
    unsigned char* ws = P.ws; const int lane = threadIdx.x & 63;
    for (int T = Tb + worker; T < Te; T += nworkers) {
        const float* src; int ld, K, k0; bf16_t* dst;
        if (T < 2048) { const int kt = T & 31, r0 = (T >> 5) * 64; src = P.in[7] + r0; ld = 4096; K = 2048; k0 = kt * 64; dst = (bf16_t*)(ws + WB_IN) + (size_t)r0 * K; }
        else if (T < 2560) { const int t2 = T - 2048, kt = t2 & 15, r0 = (t2 >> 4) * 64; const int pn = r0 >> 8, bj = (r0 >> 7) & 1, j0 = r0 & 127;
            src = P.in[26] + bj * 1024 + pn * 128 + j0; ld = 2048; K = 1024; k0 = kt * 64; dst = (bf16_t*)(ws + WB_GLU) + (size_t)r0 * K; }
        else if (T < 3584) { const int t2 = T - 2560, kt = t2 & 31, r0 = (t2 >> 5) * 64; src = P.in[30] + r0; ld = 2048; K = 2048; k0 = kt * 64; dst = (bf16_t*)(ws + WB_OUT) + (size_t)r0 * K; }
        else if (T < 9216) { const int t2 = T - 3584, kt = t2 & 31, r0 = (t2 >> 5) * 64; const int pn = r0 >> 8, bj = (r0 >> 7) & 1, j0 = r0 & 127;
            src = (bj ? P.in[33] : P.in[32]) + pn * 128 + j0; ld = DFF; K = 2048; k0 = kt * 64; dst = (bf16_t*)(ws + WB_GU) + (size_t)r0 * K; }
        else { const int t2 = T - 9216, kt = t2 % 88, r0 = (t2 / 88) * 64; src = P.in[34] + r0; ld = 2048; K = DFF; k0 = kt * 64; dst = (bf16_t*)(ws + WB_DN) + (size_t)r0 * K; }
        const float* sp = src + (size_t)k0 * ld + lane;
        float f[64];
#pragma unroll
        for (int k = 0; k < 64; ++k) f[k] = __builtin_nontemporal_load(sp + (size_t)k * ld);
        bf16_t* dp = dst + (size_t)lane * K + k0;
#pragma unroll
        for (int k8 = 0; k8 < 8; ++k8) { u32x4 wv; wv.x = pk_bf16(f[8 * k8 + 0], f[8 * k8 + 1]); wv.y = pk_bf16(f[8 * k8 + 2], f[8 * k8 + 3]); wv.z = pk_bf16(f[8 * k8 + 4], f[8 * k8 + 5]); wv.w = pk_bf16(f[8 * k8 + 6], f[8 * k8 + 7]);
            if (T >= 3584) __builtin_nontemporal_store(wv, (u32x4*)(dp + 8 * k8)); else *(u32x4*)(dp + 8 * k8) = wv; }
    }
}
__device__ __forceinline__ void phaseA(const Params& P, unsigned char* lds) {
    const int tid = threadIdx.x, bid = blockIdx.x, G = gridDim.x;
    unsigned char* ws = P.ws;
    if (bid == 0 && tid < 32) { ((unsigned*)(ws + CTR))[tid] = (tid < 2) ? (unsigned)gridDim.x : 0u; }
    convert_items(P, 0, 12032, bid * 8 + (tid >> 6), G * 8);
    for (int it = bid; it < 256; it += G) {
        const int jb = it & 31, kb = it >> 5;
        float* sl = (float*)lds;
        float* red = sl + 9 * 256;
        for (int idx = tid; idx < 9 * 256; idx += NTHR) { const int row = idx >> 8, kk = idx & 255; const float cv = row < 8 ? P.in[1][row * DM + kb * 256 + kk] : P.in[3][kb * 256 + kk]; sl[idx] = cv / (1.0f + expf(-cv)); }
        __syncthreads();
        if (tid < 384) { const int col4 = tid % 96, rg = tid / 96; f32x4 acc[9];
#pragma unroll
            for (int r = 0; r < 9; ++r) acc[r] = (f32x4){0.f, 0.f, 0.f, 0.f};
            const float* wp = P.in[4] + (size_t)(kb * 256 + rg * 64) * 12288 + jb * 384 + 4 * col4;
#pragma unroll 1
            for (int r0 = 0; r0 < 64; r0 += 8) { f32x4 wv[8];
#pragma unroll
                for (int j = 0; j < 8; ++j) wv[j] = __builtin_nontemporal_load((const f32x4*)(wp + (size_t)(r0 + j) * 12288));
#pragma unroll
                for (int j = 0; j < 8; ++j)
#pragma unroll
                    for (int row = 0; row < 9; ++row) acc[row] += sl[row * 256 + rg * 64 + r0 + j] * wv[j]; }
#pragma unroll
            for (int row = 0; row < 9; ++row) *(f32x4*)(red + (rg * 9 + row) * 384 + 4 * col4) = acc[row]; }
        __syncthreads();
        float* mp = (float*)(ws + MODP);
        for (int idx = tid; idx < 9 * 384; idx += NTHR) { const int row = idx / 384, col = idx % 384; float s = 0.f;
#pragma unroll
            for (int rg = 0; rg < 4; ++rg) s += red[(rg * 9 + row) * 384 + col];
            mp[(size_t)(kb * 9 + row) * 12288 + jb * 384 + col] = s; }
        __syncthreads();
    }
    for (int it = bid; it < 256; it += G) {
        const int t0 = it * 8;
        float* z = (float*)lds;
        float* h1 = z + 8 * 33;
        if (tid < 8 * 33) { const int r = tid / 33, f = tid % 33; const double t = (double)(t0 + r); float v;
            if (f == 0) v = (float)(t / 2048.0);
            else { const int bi = (f - 1) & 15; const double band = 1e-4 + (double)bi * ((15.0 - 1e-4) / 15.0); const double ang = 2.0 * 3.14159265358979323846 * t * band / 2048.0; v = (f <= 16) ? (float)cos(ang) : (float)(-sin(ang)); }
            z[tid] = v; }
        __syncthreads();
        const int r = tid >> 6, j = tid & 63;
        { float s = P.in[11][j]; for (int k = 0; k < 33; ++k) s += z[r * 33 + k] * P.in[10][k * 64 + j]; h1[r * 64 + j] = sinf(P.in[15][j] * s); }
        __syncthreads();
        { float s = P.in[13][j]; for (int k = 0; k < 64; ++k) s += h1[r * 64 + k] * P.in[12][k * 64 + j]; ((float*)(ws + H2F))[(size_t)j * 2048 + t0 + r] = sinf(P.in[15][64 + j] * s); }
        __syncthreads();
    }
}

typedef __attribute__((address_space(1))) unsigned long long gu64_t;
typedef __attribute__((address_space(1))) unsigned gu32_t;
template <bool WT = false> __device__ __forceinline__ void norm_rows_B(const Params& P, const float* xr, bf16_t* orow, const float* sh, const float* sc, int lane) {
    f32x4 v[8]; float ss = 0.f;
#pragma unroll
    for (int q = 0; q < 8; ++q) { v[q] = __builtin_nontemporal_load((const f32x4*)(xr + 4 * (lane + 64 * q))); ss += v[q][0] * v[q][0] + v[q][1] * v[q][1] + v[q][2] * v[q][2] + v[q][3] * v[q][3]; }
    ss = wave_sum(ss); const float r = rsqrtf(ss * (1.0f / DM) + 1e-6f);
#pragma unroll
    for (int q = 0; q < 8; ++q) { const int c0 = 4 * (lane + 64 * q); const f32x4 g = *(const f32x4*)(P.in[6] + c0); const f32x4 s1 = *(const f32x4*)(sc + c0), h1 = *(const f32x4*)(sh + c0);
        float o[4];
#pragma unroll
        for (int e = 0; e < 4; ++e) o[e] = (v[q][e] * r * g[e]) * (1.0f + s1[e]) + h1[e];
        u32x2 wv; wv.x = pk_bf16(o[0], o[1]); wv.y = pk_bf16(o[2], o[3]);
        if (WT) __hip_atomic_store((gu64_t*)(orow + c0), ((unsigned long long)wv.y << 32) | wv.x, __ATOMIC_RELAXED, __HIP_MEMORY_SCOPE_AGENT);
        else *(u32x2*)(orow + c0) = wv; }
}
__device__ __forceinline__ void norm_rows_B2(const Params& P, const float* xr, bf16_t* orow, const float* sh, const float* sc, int lane) {
    f32x4 v[2][8];
#pragma unroll
    for (int u = 0; u < 2; ++u)
#pragma unroll
        for (int q = 0; q < 8; ++q) v[u][q] = __builtin_nontemporal_load((const f32x4*)(xr + (size_t)u * 8 * DM + 4 * (lane + 64 * q)));
#pragma unroll
    for (int u = 0; u < 2; ++u) { float ss = 0.f;
#pragma unroll
        for (int q = 0; q < 8; ++q) ss += v[u][q][0] * v[u][q][0] + v[u][q][1] * v[u][q][1] + v[u][q][2] * v[u][q][2] + v[u][q][3] * v[u][q][3];
        ss = wave_sum(ss); const float r = rsqrtf(ss * (1.0f / DM) + 1e-6f);
#pragma unroll
        for (int q = 0; q < 8; ++q) { const int c0 = 4 * (lane + 64 * q); const f32x4 g = *(const f32x4*)(P.in[6] + c0); const f32x4 s1 = *(const f32x4*)(sc + c0), h1 = *(const f32x4*)(sh + c0);
            float o[4];
#pragma unroll
            for (int e = 0; e < 4; ++e) o[e] = (v[u][q][e] * r * g[e]) * (1.0f + s1[e]) + h1[e];
            u32x2 wv; wv.x = pk_bf16(o[0], o[1]); wv.y = pk_bf16(o[2], o[3]);
            *(u32x2*)(orow + (size_t)u * 8 * DM + c0) = wv; } }
}
__device__ __forceinline__ void load_tab_B(const Params& P, float* tab, int row) {
    const float* mp = (const float*)(P.ws + MODP); const float* ada_b = P.in[5];
#pragma unroll
    for (int q = 0; q < 8; ++q) { const int idx = threadIdx.x + NTHR * q; float s = ada_b[idx];
#pragma unroll
        for (int k = 0; k < 8; ++k) s += mp[(size_t)(k * 9 + row) * 12288 + idx];
        tab[idx] = s; }
}
__device__ __forceinline__ void phaseB(const Params& P, unsigned char* lds_g, LAS unsigned char* lds) {
    const int tid = threadIdx.x, bid = blockIdx.x, G = gridDim.x, w = tid >> 6, lane = tid & 63;
    unsigned char* ws = P.ws;
    const float* mp = (const float*)(ws + MODP);
    const float* ada_b = P.in[5];
    bf16_t* Hn = (bf16_t*)(ws + ACT_A);
    float* tab = (float*)lds_g;
    for (int it = bid; it < 256; it += G)
        for (int idx = tid; idx < 9 * 48; idx += NTHR) { const int row = idx / 48, j = it * 48 + idx % 48; float s = ada_b[j];
#pragma unroll
            for (int k = 0; k < 8; ++k) s += mp[(size_t)(k * 9 + row) * 12288 + j];
            ((float*)(ws + MODF))[(size_t)row * 12288 + j] = s; }
    const int NCB = (G >= 64) ? 32 : 0;
    if (bid < NCB) {
        const int cb = bid & 7;
        load_tab_B(P, tab, 8);
        __syncthreads();
#pragma unroll 2
        for (int r = 0; r < 8; ++r) { const int crow = cb * 256 + (bid >> 3) * 64 + w * 8 + r; norm_rows_B<true>(P, P.in[2] + (size_t)crow * DM, Hn + (size_t)(NTOK + crow) * DM, tab, tab + 2048, lane); }
        asm volatile("s_waitcnt vmcnt(0)" ::: "memory");
        __syncthreads();
        { gu32_t* flag = (gu32_t*)((unsigned*)(ws + CTR) + 8 + cb);
          if (tid == 0) { __hip_atomic_fetch_add(flag, 1u, __ATOMIC_RELAXED, __HIP_MEMORY_SCOPE_AGENT);
              while (__hip_atomic_load(flag, __ATOMIC_RELAXED, __HIP_MEMORY_SCOPE_AGENT) < 4u) __builtin_amdgcn_s_sleep(2);
              __builtin_amdgcn_fence(__ATOMIC_ACQUIRE, "agent"); asm volatile("s_waitcnt vmcnt(0)" ::: "memory"); }
          __syncthreads(); }
        pg8::Gemm g{(const bf16_t*)(ws + ACT_A), (const bf16_t*)(ws + WB_IN), NTOK, 0, 2048}; pg8::StaticOrder S; S.init(NTOK, 0, NCB, bid, 32);
        pg8::EpiInProj E{(bf16_t*)(ws + U_S5), (bf16_t*)(ws + PT_HY)}; pg8::gemm_phase(lds, g, S, E);
        return;
    }
    const int nw = G - NCB, wb = bid - NCB;
    if (NCB == 0) {
        load_tab_B(P, tab, 8); __syncthreads();
        for (int crow = wb * 8 + w; crow < NCTX; crow += nw * 8) norm_rows_B(P, P.in[2] + (size_t)crow * DM, Hn + (size_t)(NTOK + crow) * DM, tab, tab + 2048, lane);
        __syncthreads();
    }
    { const int g0 = (int)((long)wb * 2048 / nw), g1 = (int)((long)(wb + 1) * 2048 / nw); int curb = -1;
      for (int gr = g0; gr < g1; gr += 2) { const int b = gr >> 8;
          if (b != curb) { __syncthreads(); load_tab_B(P, tab, b); __syncthreads(); curb = b; }
          const bool two = (gr + 1 < g1) && (((gr + 1) >> 8) == b);
          const int row = gr * 8 + w;
          if (two) { norm_rows_B2(P, P.in[0] + (size_t)row * DM, Hn + (size_t)row * DM, tab, tab + 2048, lane); }
          else { norm_rows_B(P, P.in[0] + (size_t)row * DM, Hn + (size_t)row * DM, tab, tab + 2048, lane); gr -= 1; } }
      __syncthreads(); }
    for (int it = wb; it < 512; it += nw) {
        const int o = it >> 8, c0 = (it & 255) * 4;
        float* vals = (float*)lds_g;
        float* w3s = vals + 2048 * 8;
        float* red = w3s + 64 * 8;
        float* tot = red + 8 * 8;
        for (int idx = tid; idx < 64 * 8; idx += NTHR) { const int k = idx >> 3, col = idx & 7, dir = col >> 2, ch = col & 3; w3s[idx] = P.in[14][(size_t)k * 4096 + o * 2048 + dir * 1024 + c0 + ch]; }
        __syncthreads();
        float dec[8];
#pragma unroll
        for (int col = 0; col < 8; ++col) dec[col] = fabsf(P.in[16][(o * 2 + (col >> 2)) * 1024 + c0 + (col & 3)]);
        float sabs[8];
#pragma unroll
        for (int col = 0; col < 8; ++col) sabs[col] = 0.f;
        const float* h2f = (const float*)(ws + H2F);
        {
            float a[4][8];
#pragma unroll
            for (int r = 0; r < 4; ++r)
#pragma unroll
                for (int col = 0; col < 8; ++col) a[r][col] = 0.f;
#pragma unroll 1
            for (int k0 = 0; k0 < 64; k0 += 8) { f32x4 hv[8];
#pragma unroll
                for (int kk = 0; kk < 8; ++kk) hv[kk] = *(const f32x4*)(h2f + (size_t)(k0 + kk) * 2048 + 4 * tid);
#pragma unroll
                for (int kk = 0; kk < 8; ++kk) { const f32x4* wr4 = (const f32x4*)(w3s + (k0 + kk) * 8); const f32x4 w0 = wr4[0], w1 = wr4[1];
#pragma unroll
                    for (int r = 0; r < 4; ++r) { const float hk = hv[kk][r];
                        a[r][0] += hk * w0[0]; a[r][1] += hk * w0[1]; a[r][2] += hk * w0[2]; a[r][3] += hk * w0[3];
                        a[r][4] += hk * w1[0]; a[r][5] += hk * w1[1]; a[r][6] += hk * w1[2]; a[r][7] += hk * w1[3]; } } }
#pragma unroll
            for (int r = 0; r < 4; ++r) { const int t = 4 * tid + r; const float tn = (float)t * (1.0f / 2048.0f);
#pragma unroll
                for (int col = 0; col < 8; ++col) { a[r][col] *= expf(-tn * dec[col]); if (col < 4 || t > 0) sabs[col] += fabsf(a[r][col]); }
#pragma unroll
                for (int c4 = 0; c4 < 2; ++c4) *(f32x4*)(vals + t * 8 + 4 * c4) = (f32x4){a[r][4 * c4], a[r][4 * c4 + 1], a[r][4 * c4 + 2], a[r][4 * c4 + 3]}; }
        }
#pragma unroll
        for (int col = 0; col < 8; ++col) { const float sm = wave_sum(sabs[col]); if (lane == 0) red[w * 8 + col] = sm; }
        __syncthreads();
        if (tid < 4) { float sm = 0.f; for (int ww = 0; ww < 8; ++ww) sm += red[ww * 8 + tid] + red[ww * 8 + 4 + tid]; tot[tid] = 1.0f / (sm + 1e-6f); }
        __syncthreads();
        bf16_t* hg = (bf16_t*)(ws + HG) + (size_t)(o * 1024 + c0) * 4096;
#pragma unroll 4
        for (int idx = tid; idx < 2 * 2048 * 4; idx += NTHR) {
            const int t = idx & 2047, ch = (idx >> 11) & 3, dir = idx >> 13;
            const unsigned short v = f2bf(vals[t * 8 + dir * 4 + ch] * tot[ch]);
            if (dir == 0) hg[(size_t)ch * 4096 + 2048 - t] = v; else if (t > 0) hg[(size_t)ch * 4096 + 2048 + t] = v; else hg[(size_t)ch * 4096] = 0;
        }
        __syncthreads();
    }
}

__device__ __forceinline__ void s5_task(const Params& P, LAS unsigned char* lds, int item) {
    const int tid = threadIdx.x, w = tid >> 6, lane = tid & 63, fr = lane & 15, fq = lane >> 4;
    const int pair = item * 4 + (w >> 1), dir = w & 1, b = pair >> 6, g = pair & 63;
    unsigned char* ws = P.ws;
    LAS unsigned char* wl = lds + w * 13824;
    LAS float* BU = (LAS float*)wl;
    LAS unsigned char* X = wl + 8448;
    LAS float* tab = (LAS float*)(wl + 8448 + 4352);
    const int dg = dir * 64 + g;
    float ar, ai;
    { const double lr = (double)P.in[18][dg * 64 + lane], li = (double)P.in[19][dg * 64 + lane], dt = exp((double)P.in[20][dg]);
      const double ea = exp(lr * dt), car = ea * cos(li * dt), cai = ea * sin(li * dt);
      const double den = lr * lr + li * li; const double nr = car - 1.0, ni = cai;
      const double cr = (nr * lr + ni * li) / den, ci = (ni * lr - nr * li) / den;
      ar = (float)car; ai = (float)cai;
      tab[lane * 4 + 0] = ar; tab[lane * 4 + 1] = ai; tab[lane * 4 + 2] = (float)cr; tab[lane * 4 + 3] = (float)ci; }
    asm volatile("s_waitcnt lgkmcnt(0)" ::: "memory");
    bf16x4 Bf[8]; bf16x8 Cf[4]; float Dv[4];
#pragma unroll
    for (int j = 0; j < 8; ++j) { const int col = 16 * j + fr, pp = col >> 1, ri = col & 1; const float cr = tab[pp * 4 + 2], ci = tab[pp * 4 + 3];
        const f32x4 br = *(const f32x4*)(P.in[21] + ((size_t)dg * 64 + pp) * 16 + 4 * fq), bi = *(const f32x4*)(P.in[22] + ((size_t)dg * 64 + pp) * 16 + 4 * fq);
        float v[4];
#pragma unroll
        for (int e = 0; e < 4; ++e) v[e] = ri ? (cr * bi[e] + ci * br[e]) : (cr * br[e] - ci * bi[e]);
        const unsigned w0 = pk_bf16(v[0], v[1]), w1 = pk_bf16(v[2], v[3]);
        Bf[j][0] = (short)(w0 & 0xffff); Bf[j][1] = (short)(w0 >> 16); Bf[j][2] = (short)(w1 & 0xffff); Bf[j][3] = (short)(w1 >> 16); }
#pragma unroll
    for (int kk = 0; kk < 4; ++kk) { const int p0 = 16 * kk + 4 * fq;
        const f32x4 cr = *(const f32x4*)(P.in[23] + ((size_t)dg * 16 + fr) * 64 + p0), ci = *(const f32x4*)(P.in[24] + ((size_t)dg * 16 + fr) * 64 + p0);
#pragma unroll
        for (int e = 0; e < 4; ++e) { const unsigned wv = pk_bf16(cr[e], -ci[e]); Cf[kk][2 * e] = (short)(wv & 0xffff); Cf[kk][2 * e + 1] = (short)(wv >> 16); } }
#pragma unroll
    for (int e = 0; e < 4; ++e) Dv[e] = P.in[25][g * 16 + 4 * fq + e];
    const bf16_t* U = (const bf16_t*)(ws + U_S5) + (size_t)g * NROWS * 16 + 4 * fq;
    float* pbuf = (float*)(ws + PBUF);
    bf16_t* ypre = (bf16_t*)(ws + YPRE);
    f32x2 xs = (f32x2){0.f, 0.f}; const f32x2 arr = (f32x2){ar, ar}, aim = (f32x2){-ai, ai};
#define S5_ROW(c) ((c) < 16 ? (NTOK + b * CTX + (dir ? 255 - (16 * (c) + fr) : (16 * (c) + fr))) : (b * SEQ + (dir ? 2047 - (16 * (c) + fr - 256) : (16 * (c) + fr - 256))))
#define S5_CORE(c) \
        const u32x2 ucur = uq[i & 3]; const int row = S5_ROW(c); \
        { const int cn = ((c) + 4 < 144) ? (c) + 4 : 143; uq[i & 3] = *(const u32x2*)(U + (size_t)S5_ROW(cn) * 16); } \
        { bf16x4 Uf; Uf[0] = (short)(ucur.x & 0xffff); Uf[1] = (short)(ucur.x >> 16); Uf[2] = (short)(ucur.y & 0xffff); Uf[3] = (short)(ucur.y >> 16); \
          _Pragma("unroll") for (int j = 0; j < 8; ++j) { const f32x4 a = __builtin_amdgcn_mfma_f32_16x16x16bf16_1k(Bf[j], Uf, (f32x4){0.f, 0.f, 0.f, 0.f}, 0, 0, 0); \
            *(LAS f32x4*)(BU + fr * 132 + 16 * j + 4 * fq) = a; } } \
        asm volatile("s_waitcnt lgkmcnt(0)" ::: "memory"); \
        { f32x2 bu[16]; \
          _Pragma("unroll") for (int t = 0; t < 16; ++t) bu[t] = *(const LAS f32x2*)(BU + t * 132 + 2 * lane); \
          _Pragma("unroll") for (int t = 0; t < 16; ++t) { const f32x2 tmp = arr * xs + bu[t]; xs = aim * xs.yx + tmp; \
            *(LAS unsigned*)(X + t * 272 + 4 * lane) = pk_bf16(xs.x, xs.y); } } \
        asm volatile("s_waitcnt lgkmcnt(0)" ::: "memory");
#define S5_READOUT() \
        f32x4 y = (f32x4){0.f, 0.f, 0.f, 0.f}; \
        _Pragma("unroll") for (int kk = 0; kk < 4; ++kk) { const bf16x8 xf = *(const LAS bf16x8*)(X + fr * 272 + 64 * kk + 16 * fq); y = __builtin_amdgcn_mfma_f32_16x16x32_bf16(Cf[kk], xf, y, 0, 0, 0); } \
        const size_t oidx = (size_t)row * 1024 + g * 16 + 4 * fq;
    u32x2 uq[4]; f32x4 pq[4];
#pragma unroll
    for (int i = 0; i < 4; ++i) uq[i] = *(const u32x2*)(U + (size_t)S5_ROW(i) * 16);
#pragma unroll 1
    for (int c4 = 0; c4 < 16; c4 += 4) {
#pragma unroll
      for (int i = 0; i < 4; ++i) { const int c = c4 + i; S5_CORE(c) (void)row; }
    }
#pragma unroll 1
    for (int c4 = 16; c4 < 80; c4 += 4) {
#pragma unroll
      for (int i = 0; i < 4; ++i) { const int c = c4 + i; S5_CORE(c) S5_READOUT() *(f32x4*)(pbuf + oidx) = y; }
    }
    __builtin_amdgcn_fence(__ATOMIC_RELEASE, "workgroup"); __syncthreads(); __builtin_amdgcn_fence(__ATOMIC_ACQUIRE, "workgroup");
#pragma unroll
    for (int q = 0; q < 4; ++q) pq[q] = *(const f32x4*)(pbuf + (size_t)S5_ROW(80 + q) * 1024 + g * 16 + 4 * fq);
#pragma unroll 1
    for (int c4 = 80; c4 < 144; c4 += 4) {
#pragma unroll
      for (int i = 0; i < 4; ++i) { const int c = c4 + i; S5_CORE(c) S5_READOUT()
        const f32x4 pv = pq[i];
        { const int cn = (c + 4 < 144) ? c + 4 : 143; pq[i] = *(const f32x4*)(pbuf + (size_t)S5_ROW(cn) * 1024 + g * 16 + 4 * fq); }
        float o[4]; const float uu[4] = {bflo(ucur.x), bfhi(ucur.x), bflo(ucur.y), bfhi(ucur.y)};
#pragma unroll
        for (int e = 0; e < 4; ++e) o[e] = gelu_tanh(y[e] + pv[e] + Dv[e] * uu[e]);
        u32x2 wv; wv.x = pk_bf16(o[0], o[1]); wv.y = pk_bf16(o[2], o[3]);
        *(u32x2*)(ypre + oidx) = wv; }
    }
#undef S5_ROW
#undef S5_CORE
#undef S5_READOUT
}

constexpr int HY_G = 0, HY_GSZ = 8 * 514 * 16, HY_U = HY_GSZ, HY_ROW = 4112, HY_GATE = HY_U + 8 * HY_ROW, HY_H = HY_GATE + 8 * HY_ROW;
static_assert(HY_H + 8192 + 16 <= LDS_BYTES - 64, "hyena LDS");
struct HyRaw { u32x4 v[4]; unsigned nb[4]; };
__device__ __forceinline__ void hy_issue(const Params& P, HyRaw& r, int set, int c) {
    const int tid = threadIdx.x; const int ch = set * 1024 + c;
    const bf16_t* src = (const bf16_t*)(P.ws + PT_HY) + (size_t)ch * NTOK;
#pragma unroll
    for (int q = 0; q < 4; ++q) { const int chunk = tid + NTHR * q; const int b = chunk >> 8, t8 = (chunk & 255) * 8;
        const bf16_t* sp = src + b * SEQ + t8; r.v[q] = __builtin_nontemporal_load((const u32x4*)sp);
        const unsigned l = (t8 & 63) ? (unsigned)sp[-1] : 0u, rr = ((t8 + 8) & 63) ? (unsigned)sp[8] : 0u; r.nb[q] = l | (rr << 16); }
}
__device__ __forceinline__ void hy_commit(const Params& P, const HyRaw& r, LAS unsigned char* dstbuf, int set, int c) {
    const int tid = threadIdx.x; const int ch = set * 1024 + c;
    const float w0 = P.in[8][0 * 3072 + ch], w1 = P.in[8][1 * 3072 + ch], w2 = P.in[8][2 * 3072 + ch], bias = P.in[9][ch];
#pragma unroll
    for (int q = 0; q < 4; ++q) { const int chunk = tid + NTHR * q; const int b = chunk >> 8, t8 = (chunk & 255) * 8;
        const u32x4 raw = r.v[q];
        float x[10];
        x[1] = bflo(raw.x); x[2] = bfhi(raw.x); x[3] = bflo(raw.y); x[4] = bfhi(raw.y); x[5] = bflo(raw.z); x[6] = bfhi(raw.z); x[7] = bflo(raw.w); x[8] = bfhi(raw.w);
        x[0] = bflo(r.nb[q]); x[9] = bfhi(r.nb[q]);
        float o[8];
#pragma unroll
        for (int j = 0; j < 8; ++j) o[j] = w0 * x[j] + w1 * x[j + 1] + w2 * x[j + 2] + bias;
        u32x4 wv; wv.x = pk_bf16(o[0], o[1]); wv.y = pk_bf16(o[2], o[3]); wv.z = pk_bf16(o[4], o[5]); wv.w = pk_bf16(o[6], o[7]);
        *(LAS u32x4*)(dstbuf + b * HY_ROW + t8 * 2) = wv; }
}
__device__ __forceinline__ u32x4 hy_issue_H(const Params& P, int o, int c) { return ((const u32x4*)((const bf16_t*)(P.ws + HG) + (size_t)(o * 1024 + c) * 4096))[threadIdx.x]; }
__device__ __forceinline__ void hy_commit_H(LAS unsigned char* lds, const u32x4 h) {
    const int tid = threadIdx.x;
    *(LAS u32x4*)(lds + HY_H + 16 * tid) = h;
    if (tid == 0) *(LAS u32x4*)(lds + HY_H + 8192) = (u32x4){0u, 0u, 0u, 0u};
}
__device__ __forceinline__ void hy_build_G(LAS unsigned char* lds) {
    const int q = threadIdx.x;
    const u32x4 A = *(const LAS u32x4*)(lds + HY_H + 16 * (511 - q)), B = *(const LAS u32x4*)(lds + HY_H + 16 * (512 - q));
    const unsigned in[8] = {A.x, A.y, A.z, A.w, B.x, B.y, B.z, B.w};
#pragma unroll
    for (int cc = 0; cc < 8; ++cc) { const int e = 8 - cc; unsigned o4[4];
#pragma unroll
        for (int k = 0; k < 4; ++k) { if ((e & 1) == 0) o4[k] = in[e / 2 + k]; else o4[k] = (in[(e - 1) / 2 + k] >> 16) | (in[(e + 1) / 2 + k] << 16); }
        *(LAS u32x4*)(lds + HY_G + (cc * 514 + q) * 16) = (u32x4){o4[0], o4[1], o4[2], o4[3]}; }
}
__device__ __forceinline__ void hy_mma(LAS unsigned char* lds, f32x4 (&acc)[8]) {
    const int tid = threadIdx.x, w = tid >> 6, lane = tid & 63, fr = lane & 15, fq = lane >> 4, h = fr >> 3;
#pragma unroll
    for (int a = 0; a < 8; ++a) acc[a] = (f32x4){0.f, 0.f, 0.f, 0.f};
    LAS unsigned char* gbase = lds + HY_G + ((fr & 7) * 514 + (fr >> 3) - fq + 256 + 128 + 16 * w) * 16;
    LAS unsigned char* ub = lds + HY_U + (fr & 7) * HY_ROW + 16 * fq;
    const int hoff = h ? 0 : 32;
    const unsigned m_lo = h ? 0xffffffffu : 0u;
    const unsigned m_hi = h ? 0u : 0xffffffffu;
    bf16x8 frag[8];
#pragma unroll
    for (int a = 0; a < 8; ++a) frag[a] = *(const LAS bf16x8*)(gbase + 32 * a);
    u32x4 Bn = *(const LAS u32x4*)(ub + 64 * hoff);
#pragma unroll 1
    for (int K4 = 0; K4 < 24; ++K4) {
        const unsigned msk = (K4 < 8) ? m_lo : ((K4 >= 16) ? m_hi : 0xffffffffu);
#pragma unroll
        for (int kk = 0; kk < 4; ++kk) {
            __builtin_amdgcn_sched_barrier(0);
            const int ks = 4 * K4 + kk;
            u32x4 Bm = Bn; Bm.x &= msk; Bm.y &= msk; Bm.z &= msk; Bm.w &= msk;
            bf16x8 B; __builtin_memcpy(&B, &Bm, 16);
            Bn = *(const LAS u32x4*)(ub + 64 * ((ks + 1 + hoff) & 63));
            __builtin_amdgcn_sched_barrier(0);
#pragma unroll
            for (int a = 7; a >= 0; --a) {
                const int slot = (a - 2 * kk) & 7;
                acc[a] = __builtin_amdgcn_mfma_f32_16x16x32_bf16(frag[slot], B, acc[a], 0, 0, 0);
                if (a >= 6 && ks < 95) frag[slot] = *(const LAS bf16x8*)(gbase + 32 * ((a - 8) - 2 * ks));
            }
        }
    }
}
struct HyPre { HyRaw rv, rx; u32x4 h0; };
__device__ __forceinline__ void hy_prefetch(const Params& P, HyPre& pf, int c) { pf.h0 = hy_issue_H(P, 0, c); hy_issue(P, pf.rv, 0, c); hy_issue(P, pf.rx, 1, c); }
__device__ __forceinline__ int hyena_task(const Params& P, LAS unsigned char* lds, int c, HyPre& pf, int nxt) {
    const int tid = threadIdx.x, w = tid >> 6, lane = tid & 63, fr = lane & 15, fq = lane >> 4;
    hy_commit_H(lds, pf.h0); hy_commit(P, pf.rv, lds + HY_U, 0, c); hy_commit(P, pf.rx, lds + HY_GATE, 1, c);
    __syncthreads();
    hy_build_G(lds);
    __syncthreads();
    HyRaw r2; hy_issue(P, r2, 2, c); const u32x4 h1 = hy_issue_H(P, 1, c);
    f32x4 acc[8];
    hy_mma(lds, acc);
    const float bias0 = P.in[17][c], bias1 = P.in[17][1024 + c];
    u32x2 z1[8];
    const int bb = fr & 7, th = 1024 * (fr >> 3);
#pragma unroll
    for (int a = 0; a < 8; ++a) { const int t = th + 128 * w + 16 * a + 4 * fq;
        const u32x2 gv = *(const LAS u32x2*)(lds + HY_GATE + bb * HY_ROW + 2 * t), vv = *(const LAS u32x2*)(lds + HY_U + bb * HY_ROW + 2 * t);
        const float o0 = bflo(gv.x) * (acc[a][0] + bias0 * bflo(vv.x)), o1 = bfhi(gv.x) * (acc[a][1] + bias0 * bfhi(vv.x));
        const float o2 = bflo(gv.y) * (acc[a][2] + bias0 * bflo(vv.y)), o3 = bfhi(gv.y) * (acc[a][3] + bias0 * bfhi(vv.y));
        z1[a].x = pk_bf16(o0, o1); z1[a].y = pk_bf16(o2, o3); }
    __syncthreads();
#pragma unroll
    for (int a = 0; a < 8; ++a) { const int t = th + 128 * w + 16 * a + 4 * fq; *(LAS u32x2*)(lds + HY_U + bb * HY_ROW + 2 * t) = z1[a]; }
    hy_commit_H(lds, h1);
    hy_commit(P, r2, lds + HY_GATE, 2, c);
    __syncthreads();
    hy_build_G(lds);
    __syncthreads();
    if (nxt < 128 + 1024) hy_prefetch(P, pf, nxt - 128);
    hy_mma(lds, acc);
    bf16_t* yt = (bf16_t*)(P.ws + YT_HY) + (size_t)c * NTOK;
#pragma unroll
    for (int a = 0; a < 8; ++a) { const int t = th + 128 * w + 16 * a + 4 * fq;
        const u32x2 gv = *(const LAS u32x2*)(lds + HY_GATE + bb * HY_ROW + 2 * t); const u32x2 vv = *(const LAS u32x2*)(lds + HY_U + bb * HY_ROW + 2 * t);
        const float o0 = bflo(gv.x) * (acc[a][0] + bias1 * bflo(vv.x)), o1 = bfhi(gv.x) * (acc[a][1] + bias1 * bfhi(vv.x));
        const float o2 = bflo(gv.y) * (acc[a][2] + bias1 * bflo(vv.y)), o3 = bfhi(gv.y) * (acc[a][3] + bias1 * bfhi(vv.y));
        u32x2 wv; wv.x = pk_bf16(o0, o1); wv.y = pk_bf16(o2, o3);
        *(u32x2*)(yt + bb * SEQ + t) = wv; }
    __syncthreads();
    return nxt;
}

__device__ __forceinline__ void phaseD(const Params& P, LAS unsigned char* lds, int rep) {
    LAS int* slot = (LAS int*)(lds + LDS_BYTES - 64);
    unsigned* ctr = (unsigned*)(P.ws + CTR) + rep;
    const int bid = (int)blockIdx.x;
    if ((int)gridDim.x == 256) {
        int c0, n;
        if (bid < 128) { c0 = 2 * bid; n = 2;
#if !defined(NO_S5)
            s5_task(P, lds, bid); __syncthreads();
#endif
        } else { c0 = 256 + 6 * (bid - 128); n = 6; }
#if !defined(NO_HY)
        HyPre pf; hy_prefetch(P, pf, c0);
        for (int i = 0; i < n; ++i) (void)hyena_task(P, lds, c0 + i, pf, (i + 1 < n) ? 128 + c0 + i + 1 : (1 << 20));
#endif
    } else {
#if !defined(NO_S5)
        for (int it = bid; it < 128; it += gridDim.x) { s5_task(P, lds, it); __syncthreads(); }
#endif
#if !defined(NO_HY)
        for (int c = bid; c < 1024; c += gridDim.x) { HyPre pf; hy_prefetch(P, pf, c); (void)hyena_task(P, lds, c, pf, 1 << 20); }
#endif
    }
    (void)slot; (void)ctr;
}

__device__ __forceinline__ void hy_transpose(const Params& P, LAS unsigned char* lds) {
    const int tid = threadIdx.x, w = tid >> 6, lane = tid & 63;
    for (int it = blockIdx.x; it < 256; it += gridDim.x) {
        const int tok0 = it * 64;
        const bf16_t* yt = (const bf16_t*)(P.ws + YT_HY);
        { u32x4 raw[16]; const int tk = lane & 7;
#pragma unroll
          for (int i = 0; i < 16; ++i) { const int c = 8 * (i * 8 + w) + (lane >> 3); raw[i] = __builtin_nontemporal_load((const u32x4*)(yt + (size_t)c * NTOK + tok0 + 8 * tk)); }
#pragma unroll
          for (int i = 0; i < 16; ++i) { const int c = 8 * (i * 8 + w) + (lane >> 3); const unsigned wv[4] = {raw[i].x, raw[i].y, raw[i].z, raw[i].w};
#pragma unroll
            for (int j = 0; j < 8; ++j) { const unsigned short v = (unsigned short)((j & 1) ? (wv[j >> 1] >> 16) : (wv[j >> 1] & 0xffff)); *(LAS unsigned short*)(lds + (8 * tk + j) * 2052 + 2 * c) = v; } } }
        __syncthreads();
        bf16_t* mix = (bf16_t*)(P.ws + ACT_A);
        for (int r = 0; r < 8; ++r) { const int tok = 8 * w + r; unsigned wv[8]; float ss = 0.f;
#pragma unroll
            for (int j = 0; j < 8; ++j) { wv[j] = *(const LAS unsigned*)(lds + tok * 2052 + 32 * lane + 4 * j); const float a = bflo(wv[j]), b2 = bfhi(wv[j]); ss += a * a + b2 * b2; }
            ss = wave_sum(ss); const float rs = rsqrtf(ss * (1.0f / 1024.0f) + 1e-6f);
            const float* gp = P.in[29] + 16 * lane; unsigned ov[8];
#pragma unroll
            for (int j = 0; j < 8; ++j) ov[j] = pk_bf16(bflo(wv[j]) * rs * gp[2 * j], bfhi(wv[j]) * rs * gp[2 * j + 1]);
            bf16_t* op = mix + (size_t)(tok0 + tok) * DM + 1024 + 16 * lane;
            *(u32x4*)op = (u32x4){ov[0], ov[1], ov[2], ov[3]}; *(u32x4*)(op + 8) = (u32x4){ov[4], ov[5], ov[6], ov[7]}; }
        __syncthreads();
    }
}
__device__ __forceinline__ void s5_norm(const Params& P) {
    const int tid = threadIdx.x, w = tid >> 6, lane = tid & 63;
    bf16_t* mix = (bf16_t*)(P.ws + ACT_A);
    const float* gp = P.in[28] + 16 * lane;
    for (int row0 = (blockIdx.x * 8 + w) * 4; row0 < NTOK; row0 += gridDim.x * 32) {
        u32x4 r0[4], r1[4];
#pragma unroll
        for (int u = 0; u < 4; ++u) { const bf16_t* rp = mix + (size_t)(row0 + u) * DM + 16 * lane; r0[u] = *(const u32x4*)rp; r1[u] = *(const u32x4*)(rp + 8); }
#pragma unroll
        for (int u = 0; u < 4; ++u) { bf16_t* rp = mix + (size_t)(row0 + u) * DM + 16 * lane;
            const unsigned wv[8] = {r0[u].x, r0[u].y, r0[u].z, r0[u].w, r1[u].x, r1[u].y, r1[u].z, r1[u].w}; float ss = 0.f;
#pragma unroll
            for (int j = 0; j < 8; ++j) { const float a = bflo(wv[j]), b2 = bfhi(wv[j]); ss += a * a + b2 * b2; }
            ss = wave_sum(ss); const float rs = rsqrtf(ss * (1.0f / 1024.0f) + 1e-6f);
            unsigned ov[8];
#pragma unroll
            for (int j = 0; j < 8; ++j) ov[j] = pk_bf16(bflo(wv[j]) * rs * gp[2 * j], bfhi(wv[j]) * rs * gp[2 * j + 1]);
            *(u32x4*)rp = (u32x4){ov[0], ov[1], ov[2], ov[3]}; *(u32x4*)(rp + 8) = (u32x4){ov[4], ov[5], ov[6], ov[7]}; }
    }
}
template <int MODE> __device__ __forceinline__ void row_norm(const Params& P) {
    const int tid = threadIdx.x, w = tid >> 6, lane = tid & 63;
    const float* modf = (const float*)(P.ws + MODF);
    bf16_t* h2 = (bf16_t*)(P.ws + ACT_A);
    constexpr int NR = 4;
    for (int row0 = (blockIdx.x * 8 + w) * NR; row0 < NTOK; row0 += gridDim.x * 8 * NR) {
        u32x2 raw[NR][8];
#pragma unroll
        for (int u = 0; u < NR; ++u) { const bf16_t* xb = (const bf16_t*)(P.ws + PBUF) + (size_t)(row0 + u) * DM;
#pragma unroll
            for (int q = 0; q < 8; ++q) raw[u][q] = *(const u32x2*)(xb + 4 * (lane + 64 * q)); }
#pragma unroll
        for (int u = 0; u < NR; ++u) { const int row = row0 + u; float* xr = P.out + (size_t)row * DM; const int b = row >> 11;
            f32x4 v[8]; float ss = 0.f;
#pragma unroll
            for (int q = 0; q < 8; ++q) { const u32x2 rb = raw[u][q]; v[q] = (f32x4){bflo(rb.x), bfhi(rb.x), bflo(rb.y), bfhi(rb.y)}; ss += v[q][0] * v[q][0] + v[q][1] * v[q][1] + v[q][2] * v[q][2] + v[q][3] * v[q][3]; }
            ss = wave_sum(ss); const float r = rsqrtf(ss * (1.0f / DM) + 1e-6f);
#pragma unroll
            for (int q = 0; q < 8; ++q) { const int c0 = 4 * (lane + 64 * q);
                if (MODE == 0) { const f32x4 g = *(const f32x4*)(P.in[31] + c0); const f32x4 sh = *(const f32x4*)(modf + (size_t)b * 12288 + 3 * 2048 + c0), sc = *(const f32x4*)(modf + (size_t)b * 12288 + 4 * 2048 + c0);
                    float o[4];
#pragma unroll
                    for (int e = 0; e < 4; ++e) o[e] = (v[q][e] * r * g[e]) * (1.0f + sc[e]) + sh[e];
                    u32x2 wv; wv.x = pk_bf16(o[0], o[1]); wv.y = pk_bf16(o[2], o[3]); *(u32x2*)(h2 + (size_t)row * DM + c0) = wv; }
                else { const f32x4 g = *(const f32x4*)(P.in[35] + c0); __builtin_nontemporal_store(v[q] * r * g, (f32x4*)(xr + c0)); } } }
    }
}

__global__ void __launch_bounds__(NTHR, 2) mega(Params P) {
    extern __shared__ __attribute__((aligned(16))) unsigned char lds_raw[];
    LAS unsigned char* lds = (LAS unsigned char*)lds_raw;
    cg::grid_group grid = cg::this_grid();
    unsigned char* ws = P.ws;
    const int lo = P.ph_lo, hi = P.ph_hi, G = gridDim.x, bid = blockIdx.x;
#ifndef PHMASK
#define PHMASK 0x7ff
#endif
#define IN(k) (((PHMASK >> (k)) & 1) && lo <= (k) && (k) < hi)
    { volatile LAS unsigned* stw = (volatile LAS unsigned*)(lds + LDS_BYTES - 32); if (threadIdx.x < 4) stw[threadIdx.x] = 0u; }
    __syncthreads();
    XcdBarrier xbar = xcd_barrier_post((unsigned*)(ws + WS_BAR), (volatile LAS unsigned*)(lds + LDS_BYTES - 32));
    if (P.ph_hi > 1000) grid.sync();
#define SEAM(k) do { if (IN(k) && IN((k) + 1)) xcd_barrier(xbar); } while (0)
#ifndef DUPMASK
#define DUPMASK 0
#endif
#define DUP(k) ((DUPMASK >> (k)) & 1)
    if (IN(0)) { phaseA(P, lds_raw); if (DUP(0)) { __syncthreads(); phaseA(P, lds_raw); } }
    SEAM(0);
    if (IN(1)) { phaseB(P, lds_raw, lds); if (DUP(1)) { __syncthreads(); phaseB(P, lds_raw, lds); } }
    SEAM(1);
    if (IN(2)) { pg8::Gemm g{(const bf16_t*)(ws + ACT_A), (const bf16_t*)(ws + WB_IN), NTOK, 4096, 2048}; pg8::StaticOrder S; S.init(NTOK, 4096, G, bid, (G >= 64) ? 0 : 32);
        pg8::EpiInProj E{(bf16_t*)(ws + U_S5), (bf16_t*)(ws + PT_HY)}; pg8::gemm_phase(lds, g, S, E); }
    SEAM(2);
    if (IN(3)) { phaseD(P, lds, 0); if (DUP(3)) { __syncthreads(); phaseD(P, lds, 1); } }
    SEAM(3);
    if (IN(4)) { pg8::Gemm g{(const bf16_t*)(ws + YPRE), (const bf16_t*)(ws + WB_GLU), NTOK, 2048, 1024}; pg8::StaticOrder S; S.init(NTOK, 2048, G, bid, 0);
        pg8::EpiGate<0> E{(bf16_t*)(ws + ACT_A), DM, P.in[27], 1024}; pg8::gemm_phase(lds, g, S, E);
        hy_transpose(P, lds); }
    SEAM(4);
    if (IN(5)) s5_norm(P);
    SEAM(5);
    if (IN(6)) { pg8::Gemm g{(const bf16_t*)(ws + ACT_A), (const bf16_t*)(ws + WB_OUT), NTOK, 2048, 2048}; pg8::StaticOrder S; S.init(NTOK, 2048, G, bid, 0);
        pg8::EpiRes<false> E{P.in[0], (bf16_t*)(ws + PBUF), (const float*)(ws + MODF) + 2 * 2048}; pg8::gemm_phase(lds, g, S, E); }
    SEAM(6);
    if (IN(7)) row_norm<0>(P);
    SEAM(7);
    if (IN(8)) { pg8::Gemm g{(const bf16_t*)(ws + ACT_A), (const bf16_t*)(ws + WB_GU), NTOK, 11264, 2048}; pg8::StaticOrder S; S.init(NTOK, 11264, G, bid, 0);
        pg8::EpiGate<1> E{(bf16_t*)(ws + HID), DFF, nullptr, 0}; pg8::gemm_phase(lds, g, S, E); }
    SEAM(8);
    if (IN(9)) { pg8::Gemm g{(const bf16_t*)(ws + HID), (const bf16_t*)(ws + WB_DN), NTOK, 2048, DFF}; pg8::StaticOrder S; S.init(NTOK, 2048, G, bid, 0);
        pg8::EpiRes<true> E{(const void*)(ws + PBUF), (bf16_t*)(ws + PBUF), (const float*)(ws + MODF) + 5 * 2048}; pg8::gemm_phase(lds, g, S, E); }
    SEAM(9);
    if (IN(10)) row_norm<1>(P);
}

extern "C" void kernel_launch(void* const* d_in, const int* in_sizes, int n_in, void* d_out, int out_size, void* d_ws, size_t ws_size, hipStream_t stream) {
    static int grid_blocks = 0;
    if (!grid_blocks) {
        int dev = 0, cus = 0, per_cu = 0;
        hipGetDevice(&dev);
        hipDeviceGetAttribute(&cus, hipDeviceAttributeMultiprocessorCount, dev);
        if (hipFuncSetAttribute((const void*)mega, hipFuncAttributeMaxDynamicSharedMemorySize, LDS_BYTES) != hipSuccess) fprintf(stderr, "hipFuncSetAttribute failed\n");
        hipOccupancyMaxActiveBlocksPerMultiprocessor(&per_cu, (const void*)mega, NTHR, LDS_BYTES);
        if (per_cu < 1) { fprintf(stderr, "occupancy query says %d\n", per_cu); per_cu = 1; }
        (void)hipGetLastError();
        grid_blocks = cus * per_cu;
        if (ws_size < WS_END) fprintf(stderr, "workspace too small: %zu < %zu\n", ws_size, (size_t)WS_END);
        if (n_in != 36) fprintf(stderr, "unexpected n_in %d\n", n_in);
    }
    Params p{};
    for (int i = 0; i < 36; ++i) p.in[i] = (const float*)d_in[i];
    p.out = (float*)d_out; p.ws = (unsigned char*)d_ws;
#if ONE_LAUNCH
    (void)hipMemsetAsync((unsigned char*)d_ws + WS_BAR, 0, (size_t)XCD_BAR_WORDS * 4, stream);
    p.ph_lo = 0; p.ph_hi = NPHASE;
    void* args[] = {&p};
    hipError_t e = hipLaunchCooperativeKernel((const void*)mega, dim3(grid_blocks), dim3(NTHR), args, LDS_BYTES, stream);
    if (e != hipSuccess) fprintf(stderr, "cooperative launch failed: %s (grid %d)\n", hipGetErrorString(e), grid_blocks);
#else
    for (int ph = 0; ph < NPHASE; ++ph) { p.ph_lo = ph; p.ph_hi = ph + 1; hipLaunchKernelGGL(mega, dim3(grid_blocks), dim3(NTHR), LDS_BYTES, stream, p); }
#endif
}
```

```cpp
#include <hip/hip_runtime.h>
#include <hip/hip_cooperative_groups.h>
#include <cstdio>
namespace cg = cooperative_groups;

#ifndef ONE_LAUNCH
#define ONE_LAUNCH 1
#endif

#define LAS __attribute__((address_space(3)))
typedef unsigned short bf16_t;
typedef short bf16x8 __attribute__((ext_vector_type(8)));
typedef short bf16x4 __attribute__((ext_vector_type(4)));
typedef float f32x4 __attribute__((ext_vector_type(4)));
typedef float f32x2 __attribute__((ext_vector_type(2)));
typedef unsigned u32x4 __attribute__((ext_vector_type(4)));
typedef unsigned u32x2 __attribute__((ext_vector_type(2)));

constexpr int NTHR = 512;
constexpr int LDS_BYTES = 147456;
constexpr int NPHASE = 11;

constexpr int DM = 2048, NB = 8, SEQ = 2048, CTX = 256, NTOK = NB * SEQ, NCTX = NB * CTX, NROWS = NTOK + NCTX;
constexpr int DFF = 5632;

constexpr size_t WB_IN = 0;
constexpr size_t WB_GLU = WB_IN + (size_t)4096 * 2048 * 2;
constexpr size_t WB_OUT = WB_GLU + (size_t)2048 * 1024 * 2;
constexpr size_t WB_GU = WB_OUT + (size_t)2048 * 2048 * 2;
constexpr size_t WB_DN = WB_GU + (size_t)11264 * 2048 * 2;
constexpr size_t ACT_A = WB_DN + (size_t)2048 * 5632 * 2;
constexpr size_t U_S5 = ACT_A + (size_t)NROWS * 2048 * 2;
constexpr size_t PT_HY = U_S5 + (size_t)64 * NROWS * 16 * 2;
constexpr size_t YT_HY = PT_HY + (size_t)3072 * NTOK * 2;
constexpr size_t YPRE = YT_HY + (size_t)1024 * NTOK * 2;
constexpr size_t HID = U_S5;
constexpr size_t PBUF = YPRE + (size_t)NTOK * 1024 * 2;
constexpr size_t HG = PBUF + (size_t)NTOK * 1024 * 4;
constexpr size_t MODP = HG + (size_t)2 * 1024 * 4096 * 2;
constexpr size_t MODF = MODP + (size_t)8 * 9 * 12288 * 4;
constexpr size_t H2F = MODF + (size_t)9 * 12288 * 4;
constexpr size_t CTR = H2F + (size_t)2048 * 64 * 4;
constexpr size_t WS_BAR = CTR + 256;
constexpr int XCD_BAR_WORDS = 3456;
constexpr size_t WS_END = WS_BAR + (size_t)XCD_BAR_WORDS * 4;
static_assert(HID + (size_t)NTOK * DFF * 2 <= PBUF, "hidden alias");

struct Params { const float* in[36]; float* out; unsigned char* ws; int ph_lo, ph_hi; };

typedef __bf16 bf16v2_t __attribute__((ext_vector_type(2)));
__device__ __forceinline__ unsigned pk_bf16(float lo, float hi) { const f32x2 v = (f32x2){lo, hi}; const bf16v2_t b = __builtin_convertvector(v, bf16v2_t); unsigned r; __builtin_memcpy(&r, &b, 4); return r; }
__device__ __forceinline__ bf16_t f2bf(float f) { return (bf16_t)(pk_bf16(f, 0.f) & 0xffffu); }
__device__ __forceinline__ float bf2f(unsigned b) { return __uint_as_float(b << 16); }
__device__ __forceinline__ float bflo(unsigned w) { return __uint_as_float(w << 16); }
__device__ __forceinline__ float bfhi(unsigned w) { return __uint_as_float(w & 0xffff0000u); }
__device__ __forceinline__ float wave_sum(float v) { for (int o = 32; o; o >>= 1) v += __shfl_xor(v, o); return v; }
__device__ __forceinline__ float sigmoidf_(float x) { return __builtin_amdgcn_rcpf(1.0f + __builtin_amdgcn_exp2f(-1.4426950408889634f * x)); }
__device__ __forceinline__ float gelu_tanh(float x) { const float u = 0.7978845608028654f * (x + 0.044715f * x * x * x); const float e = __builtin_amdgcn_exp2f(2.8853900817779268f * u); return x * (1.0f - __builtin_amdgcn_rcpf(1.0f + e)); }

namespace pg8 {
constexpr int BM = 256, BK = 64, HALF = 128, HTB = HALF * BK * 2, STAGE_BYTES = 8 * HTB, NXCD = 8, WGM = 8;
__device__ __forceinline__ int lds_byte(int r, int c) { const int st = (r >> 4) * 2 + (c >> 5), rr = r & 15, cc = c & 31, ob = rr * 64 + cc * 2; return st * 1024 + (ob ^ (((ob >> 9) & 1) << 5)); }
__device__ __forceinline__ void stage_rc(int b, int& R, int& C) { const int st = b / 1024, sb = b % 1024, swz = sb ^ (((sb >> 9) & 1) << 5); R = (st >> 1) * 16 + swz / 64; C = (st & 1) * 32 + (swz % 64) / 2; }
__device__ __forceinline__ int perm32(int rho) { const int n = rho >> 4, i = rho & 15; return 8 * (i >> 2) + 4 * n + (i & 3); }
struct Unit { int pm, pn; };
struct Gemm { const bf16_t* A; const bf16_t* Bt; int M, N, K; };

struct StaticOrder {
    int nM, nN, nwg, G, c, extra;
    __device__ void init(int M, int N, int G_, int c_, int extra_) { nM = M / BM; nN = N / BM; nwg = nM * nN; G = G_; c = c_; extra = extra_; }
    __device__ bool next(int i, Unit& u) const {
        const long L = (long)i * G + c;
        if (L >= nwg) { const int j = (int)(L - nwg); if (j >= extra) return false; u.pm = nM + (j & 7); u.pn = j >> 3; return true; }
        int wgid = (int)L; { const int q = nwg / NXCD, r = nwg % NXCD, xcd = wgid % NXCD, off = wgid / NXCD; wgid = (xcd < r ? xcd * (q + 1) : r * (q + 1) + (xcd - r) * q) + off; }
        const int nig = WGM * nN, gid = wgid / nig, fm = gid * WGM, gsz = (nM - fm) < WGM ? (nM - fm) : WGM;
        u.pm = fm + ((wgid % nig) % gsz); u.pn = (wgid % nig) / gsz; return true;
    }
};

template <class Epi>
__device__ __forceinline__ void gemm_phase(LAS unsigned char* lds, const Gemm g, const StaticOrder& S, const Epi& E) {
    const int tid = threadIdx.x, wid = __builtin_amdgcn_readfirstlane(tid >> 6), lane = tid & 63, wr = wid >> 2, wc = wid & 3, fr = lane & 15, fq = lane >> 4;
    const int K = g.K, nt = K / BK;
    unsigned voffA[2], voffB[2];
#pragma unroll
    for (int i = 0; i < 2; ++i) { int R, C; stage_rc(tid * 16 + i * 8192, R, C); const int Rb = Epi::PERM ? ((R & ~31) + perm32(R & 31)) : R;
        voffA[i] = (unsigned)(R * K + C) * 2u; voffB[i] = (unsigned)(Rb * K + C) * 2u; }
    const size_t kstep = (size_t)(BK * 2);
    const size_t hstep = (size_t)HALF * K * 2;
    const size_t tstep = 2 * hstep;
    const unsigned ldsw = (unsigned)wid * 1024u;
    const int aoff = lds_byte(wr * 64 + fr, fq * 8), boff = lds_byte(wc * 32 + fr, fq * 8);
#define PG8_SA(b, h) (((b) * 2 + (h)) * HTB)
#define PG8_SB(b, h) ((4 + (b) * 2 + (h)) * HTB)
#define PG8_STAGE(bufoff, gbase, voff) do { _Pragma("unroll") for (int _i = 0; _i < 2; ++_i) \
        __builtin_amdgcn_global_load_lds((const unsigned*)((const char*)(gbase) + (voff)[_i]), (LAS unsigned*)(lds + (bufoff) + ldsw + _i * 8192), 16, 0, 0); } while (0)
#define PG8_LDA(dst, b, h) do { _Pragma("unroll") for (int m = 0; m < 4; ++m) _Pragma("unroll") for (int k = 0; k < 2; ++k) dst[m][k] = *(const LAS bf16x8*)(lds + PG8_SA(b, h) + aoff + m * 2048 + k * 1024); } while (0)
#define PG8_LDB(dst, b, h) do { _Pragma("unroll") for (int n = 0; n < 2; ++n) _Pragma("unroll") for (int k = 0; k < 2; ++k) dst[n][k] = *(const LAS bf16x8*)(lds + PG8_SB(b, h) + boff + n * 2048 + k * 1024); } while (0)
#define PG8_MMA(ai, bj, At, Bt) do { __builtin_amdgcn_s_setprio(1); _Pragma("unroll") for (int m = 0; m < 4; ++m) _Pragma("unroll") for (int n = 0; n < 2; ++n) _Pragma("unroll") for (int k = 0; k < 2; ++k) \
        acc[ai][bj][m][n] = __builtin_amdgcn_mfma_f32_16x16x32_bf16(Bt[n][k], At[m][k], acc[ai][bj][m][n], 0, 0, 0); __builtin_amdgcn_s_setprio(0); } while (0)
#define PG8_WAIT_V(n) asm volatile("s_waitcnt vmcnt(" #n ")" ::: "memory")
#define PG8_WAIT_L(n) asm volatile("s_waitcnt lgkmcnt(" #n ")" ::: "memory")
#define PG8_BAR __builtin_amdgcn_s_barrier()
#define PG8_SCHED __builtin_amdgcn_sched_barrier(0)
    Unit cur, nxt; int ui = 0;
    if (!S.next(0, cur)) return;
    f32x4 acc[2][2][4][2];
#pragma unroll
    for (int a = 0; a < 2; ++a)
#pragma unroll
        for (int b = 0; b < 2; ++b)
#pragma unroll
            for (int m = 0; m < 4; ++m)
#pragma unroll
                for (int n = 0; n < 2; ++n) acc[a][b][m][n] = (f32x4){0.f, 0.f, 0.f, 0.f};
    bf16x8 At[4][2], B0[2][2], B1[2][2];
    const char* cA = (const char*)g.A + (size_t)cur.pm * tstep; const char* cB = (const char*)g.Bt + (size_t)cur.pn * tstep;
    PG8_STAGE(PG8_SB(0, 0), cB, voffB); PG8_STAGE(PG8_SA(0, 0), cA, voffA); PG8_STAGE(PG8_SB(0, 1), cB + hstep, voffB); PG8_STAGE(PG8_SA(0, 1), cA + hstep, voffA);
    if (wr == 1) PG8_BAR;
    PG8_WAIT_V(4); PG8_BAR;
    PG8_STAGE(PG8_SB(1, 0), cB + kstep, voffB); PG8_STAGE(PG8_SA(1, 0), cA + kstep, voffA); PG8_STAGE(PG8_SB(1, 1), cB + hstep + kstep, voffB);
    PG8_WAIT_V(6); PG8_BAR;
    for (;;) {
        const bool has_next = S.next(ui + 1, nxt);
        const char* nA = has_next ? (const char*)g.A + (size_t)nxt.pm * tstep : cA; const char* nB = has_next ? (const char*)g.Bt + (size_t)nxt.pn * tstep : cB;
        for (int t = 0; t < nt; t += 2) {
            const bool last = (t == nt - 2);
            const char* a1 = cA + (size_t)(t + 1) * kstep;
            const char* a2 = last ? nA : cA + (size_t)(t + 2) * kstep; const char* b2 = last ? nB : cB + (size_t)(t + 2) * kstep;
            const char* a3 = a2 + kstep; const char* b3 = b2 + kstep;
            PG8_LDB(B0, 0, 0); PG8_SCHED; PG8_LDA(At, 0, 0); PG8_STAGE(PG8_SA(1, 1), a1 + hstep, voffA);
            PG8_WAIT_L(8); PG8_BAR; PG8_WAIT_L(0); PG8_MMA(0, 0, At, B0); PG8_BAR; PG8_SCHED;
            PG8_LDB(B1, 0, 1); PG8_STAGE(PG8_SB(0, 0), b2, voffB);
            PG8_BAR; PG8_WAIT_L(0); PG8_MMA(0, 1, At, B1); PG8_BAR;
            PG8_LDA(At, 0, 1); PG8_STAGE(PG8_SA(0, 0), a2, voffA);
            PG8_BAR; PG8_WAIT_L(0); PG8_MMA(1, 0, At, B0); PG8_BAR; PG8_SCHED;
            PG8_STAGE(PG8_SB(0, 1), b2 + hstep, voffB);
            PG8_WAIT_V(6); PG8_BAR; PG8_MMA(1, 1, At, B1); PG8_BAR;
            PG8_LDB(B0, 1, 0); PG8_SCHED; PG8_LDA(At, 1, 0); PG8_STAGE(PG8_SA(0, 1), a2 + hstep, voffA);
            PG8_WAIT_L(8); PG8_BAR; PG8_WAIT_L(0); PG8_MMA(0, 0, At, B0); PG8_BAR; PG8_SCHED;
            PG8_LDB(B1, 1, 1); PG8_STAGE(PG8_SB(1, 0), b3, voffB);
            PG8_BAR; PG8_WAIT_L(0); PG8_MMA(0, 1, At, B1); PG8_BAR;
            PG8_LDA(At, 1, 1); PG8_STAGE(PG8_SA(1, 0), a3, voffA);
            PG8_BAR; PG8_WAIT_L(0); PG8_MMA(1, 0, At, B0); PG8_BAR; PG8_SCHED;
            PG8_STAGE(PG8_SB(1, 1), b3 + hstep, voffB);
            PG8_WAIT_V(6); PG8_BAR; PG8_MMA(1, 1, At, B1); PG8_BAR;
        }
        E(acc, cur, wr, wc, fr, fq);
        if (!has_next) break;
#pragma unroll
        for (int a = 0; a < 2; ++a)
#pragma unroll
            for (int b = 0; b < 2; ++b)
#pragma unroll
                for (int m = 0; m < 4; ++m)
#pragma unroll
                    for (int n = 0; n < 2; ++n) acc[a][b][m][n] = (f32x4){0.f, 0.f, 0.f, 0.f};
        cur = nxt; cA = nA; cB = nB; ++ui;
    }
    PG8_WAIT_V(0);
    if (wr == 0) PG8_BAR;
    PG8_BAR;
#undef PG8_SA
#undef PG8_SB
#undef PG8_STAGE
#undef PG8_LDA
#undef PG8_LDB
#undef PG8_MMA
#undef PG8_WAIT_V
#undef PG8_WAIT_L
#undef PG8_BAR
#undef PG8_SCHED
}

struct EpiInProj {
    static constexpr bool PERM = true;
    bf16_t* U; bf16_t* PT;
    __device__ __forceinline__ void operator()(const f32x4 (&acc)[2][2][4][2], const Unit& u, int wr, int wc, int fr, int fq) const {
        const int row0 = u.pm * BM + wr * 64 + fr, colb = u.pn * BM + wc * 32 + 8 * fq;
#pragma unroll
        for (int ai = 0; ai < 2; ++ai)
#pragma unroll
            for (int m = 0; m < 4; ++m) { const int row = row0 + ai * HALF + m * 16;
#pragma unroll
                for (int bj = 0; bj < 2; ++bj) { const int col = colb + bj * HALF; const f32x4 v0 = acc[ai][bj][m][0], v1 = acc[ai][bj][m][1];
                    if (u.pn < 4) { u32x4 w; w.x = pk_bf16(v0[0], v0[1]); w.y = pk_bf16(v0[2], v0[3]); w.z = pk_bf16(v1[0], v1[1]); w.w = pk_bf16(v1[2], v1[3]);
                        *(u32x4*)(U + ((size_t)(col >> 4) * NROWS + row) * 16 + (col & 15)) = w; }
                    else { bf16_t* p = PT + (size_t)(col - 1024) * NTOK + row;
#pragma unroll
                        for (int j = 0; j < 4; ++j) { p[(size_t)j * NTOK] = f2bf(v0[j]); p[(size_t)(4 + j) * NTOK] = f2bf(v1[j]); } } } }
    }
};
template <int KIND  > struct EpiGate {
    static constexpr bool PERM = true;
    bf16_t* O; int ldo; const float* bias; int boff;
    __device__ __forceinline__ void operator()(const f32x4 (&acc)[2][2][4][2], const Unit& u, int wr, int wc, int fr, int fq) const {
        const int row0 = u.pm * BM + wr * 64 + fr, col0 = u.pn * HALF + wc * 32 + 8 * fq;
        f32x4 ba[2], bb[2];
#pragma unroll
        for (int n = 0; n < 2; ++n) { if (KIND == 0) { ba[n] = *(const f32x4*)(bias + col0 + 4 * n); bb[n] = *(const f32x4*)(bias + boff + col0 + 4 * n); } else { ba[n] = (f32x4){0.f, 0.f, 0.f, 0.f}; bb[n] = ba[n]; } }
#pragma unroll
        for (int ai = 0; ai < 2; ++ai)
#pragma unroll
            for (int m = 0; m < 4; ++m) { const int row = row0 + ai * HALF + m * 16; float o[8];
#pragma unroll
                for (int n = 0; n < 2; ++n)
#pragma unroll
                    for (int j = 0; j < 4; ++j) { const float a = acc[ai][0][m][n][j] + ba[n][j], b = acc[ai][1][m][n][j] + bb[n][j];
                        o[4 * n + j] = (KIND == 0) ? a * sigmoidf_(b) : (a * sigmoidf_(a)) * b; }
                u32x4 w; w.x = pk_bf16(o[0], o[1]); w.y = pk_bf16(o[2], o[3]); w.z = pk_bf16(o[4], o[5]); w.w = pk_bf16(o[6], o[7]);
                *(u32x4*)(O + (size_t)row * ldo + col0) = w; }
    }
};
template <bool RES_BF16> struct EpiRes {
    static constexpr bool PERM = false;
    const void* res; bf16_t* out; const float* gate;
    __device__ __forceinline__ void operator()(const f32x4 (&acc)[2][2][4][2], const Unit& u, int wr, int wc, int fr, int fq) const {
        const int row0 = u.pm * BM + wr * 64 + fr, col0 = u.pn * BM + wc * 32 + 4 * fq;
        const float* gp = gate + (size_t)(u.pm >> 3) * 12288 + col0;
        f32x4 gv[2][2];
#pragma unroll
        for (int bj = 0; bj < 2; ++bj)
#pragma unroll
            for (int n = 0; n < 2; ++n) gv[bj][n] = *(const f32x4*)(gp + bj * HALF + n * 16);
#pragma unroll
        for (int ai = 0; ai < 2; ++ai)
#pragma unroll
            for (int m = 0; m < 4; ++m) { const size_t ro = (size_t)(row0 + ai * HALF + m * 16) * DM + col0;
#pragma unroll
                for (int bj = 0; bj < 2; ++bj)
#pragma unroll
                    for (int n = 0; n < 2; ++n) { const size_t o = ro + bj * HALF + n * 16; f32x4 r;
                        if (RES_BF16) { const u32x2 rb = *(const u32x2*)((const bf16_t*)res + o); r = (f32x4){bflo(rb.x), bfhi(rb.x), bflo(rb.y), bfhi(rb.y)}; }
                        else r = *(const f32x4*)((const float*)res + o);
                        const f32x4 v = r + gv[bj][n] * acc[ai][bj][m][n];
                        u32x2 wv; wv.x = pk_bf16(v[0], v[1]); wv.y = pk_bf16(v[2], v[3]); *(u32x2*)(out + o) = wv; } }
    }
};
}

#define XB_TMO      128
#define XB_XCNT(j)  (256  + 64 * (j))
#define XB_XSUB(j)  (1280 + 64 * (j))
#define XB_XGEN(j)  (2304 + 64 * (j))
#define XB_TOP      3328
#define XB_TOPGEN   3392
#define XB_SPIN_CAP (1u << 22)
__device__ __forceinline__ unsigned xb_ld(unsigned* p)              { return __hip_atomic_load(p, __ATOMIC_RELAXED, __HIP_MEMORY_SCOPE_AGENT); }
__device__ __forceinline__ unsigned xb_add(unsigned* p, unsigned v) { return __hip_atomic_fetch_add(p, v, __ATOMIC_RELAXED, __HIP_MEMORY_SCOPE_AGENT); }
__device__ __forceinline__ unsigned xb_xcc_id() { return (unsigned)__builtin_amdgcn_s_getreg((3 << 11) | 20) & 0xFu; }
#define XB_SPIN(cond, bar) do { unsigned _sp = 0; while (cond) { __builtin_amdgcn_s_sleep(1); \
    if ((++_sp & 255u) == 0u) { if (xb_ld(&(bar)[XB_TMO])) break; if (_sp > XB_SPIN_CAP) { atomicAdd(&(bar)[XB_TMO], 1u); break; } } } } while (0)
struct XcdBarrier { unsigned* bar; unsigned x; volatile LAS unsigned* st; };
__device__ __forceinline__ XcdBarrier xcd_barrier_post(unsigned* bar, volatile LAS unsigned* st) {
    XcdBarrier b; b.bar = bar; b.x = xb_xcc_id(); b.st = st;
    if (threadIdx.x == 0) (void)xb_add(&bar[XB_XCNT(b.x)], 1u);
    return b;
}
__device__ __forceinline__ void xcd_barrier_complete(unsigned* bar, unsigned x, unsigned& nloc, unsigned& nx) {
    const unsigned G = gridDim.x * gridDim.y * gridDim.z;
    unsigned sum, cnt, mine, sp = 0u;
    for (;;) {
        sum = 0u; cnt = 0u; mine = 0u;
#pragma unroll
        for (unsigned j = 0; j < 16; ++j) { const unsigned c = xb_ld(&bar[XB_XCNT(j)]); sum += c; cnt += (c > 0u) ? 1u : 0u; mine = (j == x) ? c : mine; }
        if (sum == G) break;
        __builtin_amdgcn_s_sleep(1);
        if ((++sp & 255u) == 0u) { if (xb_ld(&bar[XB_TMO])) break; if (sp > XB_SPIN_CAP) { atomicAdd(&bar[XB_TMO], 1u); break; } }
    }
    nloc = mine > 0u ? mine : 1u; nx = cnt > 0u ? cnt : 1u;
}
__device__ __forceinline__ void xcd_barrier(const XcdBarrier& b) {
    asm volatile("s_waitcnt vmcnt(0)" ::: "memory");
    __syncthreads();
    if (threadIdx.x == 0) {
        unsigned* bar = b.bar;
        __builtin_amdgcn_s_waitcnt(0);
        unsigned nloc = b.st[0], nx = b.st[1];
        if (nloc == 0u) { xcd_barrier_complete(bar, b.x, nloc, nx); b.st[0] = nloc; b.st[1] = nx; }
        const unsigned old = xb_add(&bar[XB_XSUB(b.x)], 1u);
        const unsigned gen = old / nloc;
        if (old + 1u == (gen + 1u) * nloc) {
            __builtin_amdgcn_fence(__ATOMIC_RELEASE, "agent");
            asm volatile("s_waitcnt vmcnt(0)" ::: "memory");
            const unsigned og = xb_add(&bar[XB_TOP], 1u);
            const unsigned tg = og / nx;
            if (og + 1u == (tg + 1u) * nx) xb_add(&bar[XB_TOPGEN], 1u);
            else XB_SPIN(xb_ld(&bar[XB_TOPGEN]) == tg, bar);
            __builtin_amdgcn_fence(__ATOMIC_ACQUIRE, "agent");
            xb_add(&bar[XB_XGEN(b.x)], 1u);
            asm volatile("s_waitcnt vmcnt(0)" ::: "memory");
        } else {
            XB_SPIN(xb_ld(&bar[XB_XGEN(b.x)]) == gen, bar);
            __builtin_amdgcn_fence(__ATOMIC_ACQUIRE, "agent");
            asm volatile("s_waitcnt vmcnt(0)" ::: "memory");
        }
    }
    __syncthreads();
}

__device__ __forceinline__ void convert_items(const Params& P, int Tb, int Te, int worker, int nworkers) {
    unsigned char* ws = P.ws; const int lane = threadIdx.x & 63;
    for (int T = Tb + worker; T < Te; T += nworkers) {
        const float* src; int ld, K, k0; bf16_t* dst;
        if (T < 2048) { const int kt = T & 31, r0 = (T >> 5) * 64; src = P.in[7] + r0; ld = 4096; K = 2048; k0 = kt * 64; dst = (bf16_t*)(ws + WB_IN) + (size_t)r0 * K; }
        else if (T < 2560) { const int t2 = T - 2048, kt = t2 & 15, r0 = (t2 >> 4) * 64; const int pn = r0 >> 8, bj = (r0 >> 7) & 1, j0 = r0 & 127;
            src = P.in[26] + bj * 1024 + pn * 128 + j0; ld = 2048; K = 1024; k0 = kt * 64; dst = (bf16_t*)(ws + WB_GLU) + (size_t)r0 * K; }
        else if (T < 3584) { const int t2 = T - 2560, kt = t2 & 31, r0 = (t2 >> 5) * 64; src = P.in[30] + r0; ld = 2048; K = 2048; k0 = kt * 64; dst = (bf16_t*)(ws + WB_OUT) + (size_t)r0 * K; }
        else if (T < 9216) { const int t2 = T - 3584, kt = t2 & 31, r0 = (t2 >> 5) * 64; const int pn = r0 >> 8, bj = (r0 >> 7) & 1, j0 = r0 & 127;
            src = (bj ? P.in[33] : P.in[32]) + pn * 128 + j0; ld = DFF; K = 2048; k0 = kt * 64; dst = (bf16_t*)(ws + WB_GU) + (size_t)r0 * K; }
        else { const int t2 = T - 9216, kt = t2 % 88, r0 = (t2 / 88) * 64; src = P.in[34] + r0; ld = 2048; K = DFF; k0 = kt * 64; dst = (bf16_t*)(ws + WB_DN) + (size_t)r0 * K; }
        const float* sp = src + (size_t)k0 * ld + lane;
        float f[64];
#pragma unroll
        for (int k = 0; k < 64; ++k) f[k] = __builtin_nontemporal_load(sp + (size_t)k * ld);
        bf16_t* dp = dst + (size_t)lane * K + k0;
#pragma unroll
        for (int k8 = 0; k8 < 8; ++k8) { u32x4 wv; wv.x = pk_bf16(f[8 * k8 + 0], f[8 * k8 + 1]); wv.y = pk_bf16(f[8 * k8 + 2], f[8 * k8 + 3]); wv.z = pk_bf16(f[8 * k8 + 4], f[8 * k8 + 5]); wv.w = pk_bf16(f[8 * k8 + 6], f[8 * k8 + 7]);
            if (T >= 3584) __builtin_nontemporal_store(wv, (u32x4*)(dp + 8 * k8)); else *(u32x4*)(dp + 8 * k8) = wv; }
    }
}
__device__ __forceinline__ void phaseA(const Params& P, unsigned char* lds) {
    const int tid = threadIdx.x, bid = blockIdx.x, G = gridDim.x;
    unsigned char* ws = P.ws;
    if (bid == 0 && tid < 32) { ((unsigned*)(ws + CTR))[tid] = (tid < 2) ? (unsigned)gridDim.x : 0u; }
    convert_items(P, 0, 12032, bid * 8 + (tid >> 6), G * 8);
    for (int it = bid; it < 256; it += G) {
        const int jb = it & 31, kb = it >> 5;
        float* sl = (float*)lds;
        float* red = sl + 9 * 256;
        for (int idx = tid; idx < 9 * 256; idx += NTHR) { const int row = idx >> 8, kk = idx & 255; const float cv = row < 8 ? P.in[1][row * DM + kb * 256 + kk] : P.in[3][kb * 256 + kk]; sl[idx] = cv / (1.0f + expf(-cv)); }
        __syncthreads();
        if (tid < 384) { const int col4 = tid % 96, rg = tid / 96; f32x4 acc[9];
#pragma unroll
            for (int r = 0; r < 9; ++r) acc[r] = (f32x4){0.f, 0.f, 0.f, 0.f};
            const float* wp = P.in[4] + (size_t)(kb * 256 + rg * 64) * 12288 + jb * 384 + 4 * col4;
#pragma unroll 1
            for (int r0 = 0; r0 < 64; r0 += 8) { f32x4 wv[8];
#pragma unroll
                for (int j = 0; j < 8; ++j) wv[j] = __builtin_nontemporal_load((const f32x4*)(wp + (size_t)(r0 + j) * 12288));
#pragma unroll
                for (int j = 0; j < 8; ++j)
#pragma unroll
                    for (int row = 0; row < 9; ++row) acc[row] += sl[row * 256 + rg * 64 + r0 + j] * wv[j]; }
#pragma unroll
            for (int row = 0; row < 9; ++row) *(f32x4*)(red + (rg * 9 + row) * 384 + 4 * col4) = acc[row]; }
        __syncthreads();
        float* mp = (float*)(ws + MODP);
        for (int idx = tid; idx < 9 * 384; idx += NTHR) { const int row = idx / 384, col = idx % 384; float s = 0.f;
#pragma unroll
            for (int rg = 0; rg < 4; ++rg) s += red[(rg * 9 + row) * 384 + col];
            mp[(size_t)(kb * 9 + row) * 12288 + jb * 384 + col] = s; }
        __syncthreads();
    }
    for (int it = bid; it < 256; it += G) {
        const int t0 = it * 8;
        float* z = (float*)lds;
        float* h1 = z + 8 * 33;
        if (tid < 8 * 33) { const int r = tid / 33, f = tid % 33; const double t = (double)(t0 + r); float v;
            if (f == 0) v = (float)(t / 2048.0);
            else { const int bi = (f - 1) & 15; const double band = 1e-4 + (double)bi * ((15.0 - 1e-4) / 15.0); const double ang = 2.0 * 3.14159265358979323846 * t * band / 2048.0; v = (f <= 16) ? (float)cos(ang) : (float)(-sin(ang)); }
            z[tid] = v; }
        __syncthreads();
        const int r = tid >> 6, j = tid & 63;
        { float s = P.in[11][j]; for (int k = 0; k < 33; ++k) s += z[r * 33 + k] * P.in[10][k * 64 + j]; h1[r * 64 + j] = sinf(P.in[15][j] * s); }
        __syncthreads();
        { float s = P.in[13][j]; for (int k = 0; k < 64; ++k) s += h1[r * 64 + k] * P.in[12][k * 64 + j]; ((float*)(ws + H2F))[(size_t)j * 2048 + t0 + r] = sinf(P.in[15][64 + j] * s); }
        __syncthreads();
    }
}

typedef __attribute__((address_space(1))) unsigned long long gu64_t;
typedef __attribute__((address_space(1))) unsigned gu32_t;
template <bool WT = false> __device__ __forceinline__ void norm_rows_B(const Params& P, const float* xr, bf16_t* orow, const float* sh, const float* sc, int lane) {
    f32x4 v[8]; float ss = 0.f;
#pragma unroll
    for (int q = 0; q < 8; ++q) { v[q] = __builtin_nontemporal_load((const f32x4*)(xr + 4 * (lane + 64 * q))); ss += v[q][0] * v[q][0] + v[q][1] * v[q][1] + v[q][2] * v[q][2] + v[q][3] * v[q][3]; }
    ss = wave_sum(ss); const float r = rsqrtf(ss * (1.0f / DM) + 1e-6f);
#pragma unroll
    for (int q = 0; q < 8; ++q) { const int c0 = 4 * (lane + 64 * q); const f32x4 g = *(const f32x4*)(P.in[6] + c0); const f32x4 s1 = *(const f32x4*)(sc + c0), h1 = *(const f32x4*)(sh + c0);
        float o[4];
#pragma unroll
        for (int e = 0; e < 4; ++e) o[e] = (v[q][e] * r * g[e]) * (1.0f + s1[e]) + h1[e];
        u32x2 wv; wv.x = pk_bf16(o[0], o[1]); wv.y = pk_bf16(o[2], o[3]);
        if (WT) __hip_atomic_store((gu64_t*)(orow + c0), ((unsigned long long)wv.y << 32) | wv.x, __ATOMIC_RELAXED, __HIP_MEMORY_SCOPE_AGENT);
        else *(u32x2*)(orow + c0) = wv; }
}
__device__ __forceinline__ void norm_rows_B2(const Params& P, const float* xr, bf16_t* orow, const float* sh, const float* sc, int lane) {
    f32x4 v[2][8];
#pragma unroll
    for (int u = 0; u < 2; ++u)
#pragma unroll
        for (int q = 0; q < 8; ++q) v[u][q] = __builtin_nontemporal_load((const f32x4*)(xr + (size_t)u * 8 * DM + 4 * (lane + 64 * q)));
#pragma unroll
    for (int u = 0; u < 2; ++u) { float ss = 0.f;
#pragma unroll
        for (int q = 0; q < 8; ++q) ss += v[u][q][0] * v[u][q][0] + v[u][q][1] * v[u][q][1] + v[u][q][2] * v[u][q][2] + v[u][q][3] * v[u][q][3];
        ss = wave_sum(ss); const float r = rsqrtf(ss * (1.0f / DM) + 1e-6f);
#pragma unroll
        for (int q = 0; q < 8; ++q) { const int c0 = 4 * (lane + 64 * q); const f32x4 g = *(const f32x4*)(P.in[6] + c0); const f32x4 s1 = *(const f32x4*)(sc + c0), h1 = *(const f32x4*)(sh + c0);
            float o[4];
#pragma unroll
            for (int e = 0; e < 4; ++e) o[e] = (v[u][q][e] * r * g[e]) * (1.0f + s1[e]) + h1[e];
            u32x2 wv; wv.x = pk_bf16(o[0], o[1]); wv.y = pk_bf16(o[2], o[3]);
            *(u32x2*)(orow + (size_t)u * 8 * DM + c0) = wv; } }
}
__device__ __forceinline__ void load_tab_B(const Params& P, float* tab, int row) {
    const float* mp = (const float*)(P.ws + MODP); const float* ada_b = P.in[5];
#pragma unroll
    for (int q = 0; q < 8; ++q) { const int idx = threadIdx.x + NTHR * q; float s = ada_b[idx];
#pragma unroll
        for (int k = 0; k < 8; ++k) s += mp[(size_t)(k * 9 + row) * 12288 + idx];
        tab[idx] = s; }
}
__device__ __forceinline__ void phaseB(const Params& P, unsigned char* lds_g, LAS unsigned char* lds) {
    const int tid = threadIdx.x, bid = blockIdx.x, G = gridDim.x, w = tid >> 6, lane = tid & 63;
    unsigned char* ws = P.ws;
    const float* mp = (const float*)(ws + MODP);
    const float* ada_b = P.in[5];
    bf16_t* Hn = (bf16_t*)(ws + ACT_A);
    float* tab = (float*)lds_g;
    for (int it = bid; it < 256; it += G)
        for (int idx = tid; idx < 9 * 48; idx += NTHR) { const int row = idx / 48, j = it * 48 + idx % 48; float s = ada_b[j];
#pragma unroll
            for (int k = 0; k < 8; ++k) s += mp[(size_t)(k * 9 + row) * 12288 + j];
            ((float*)(ws + MODF))[(size_t)row * 12288 + j] = s; }
    const int NCB = (G >= 64) ? 32 : 0;
    if (bid < NCB) {
        const int cb = bid & 7;
        load_tab_B(P, tab, 8);
        __syncthreads();
#pragma unroll 2
        for (int r = 0; r < 8; ++r) { const int crow = cb * 256 + (bid >> 3) * 64 + w * 8 + r; norm_rows_B<true>(P, P.in[2] + (size_t)crow * DM, Hn + (size_t)(NTOK + crow) * DM, tab, tab + 2048, lane); }
        asm volatile("s_waitcnt vmcnt(0)" ::: "memory");
        __syncthreads();
        { gu32_t* flag = (gu32_t*)((unsigned*)(ws + CTR) + 8 + cb);
          if (tid == 0) { __hip_atomic_fetch_add(flag, 1u, __ATOMIC_RELAXED, __HIP_MEMORY_SCOPE_AGENT);
              while (__hip_atomic_load(flag, __ATOMIC_RELAXED, __HIP_MEMORY_SCOPE_AGENT) < 4u) __builtin_amdgcn_s_sleep(2);
              __builtin_amdgcn_fence(__ATOMIC_ACQUIRE, "agent"); asm volatile("s_waitcnt vmcnt(0)" ::: "memory"); }
          __syncthreads(); }
        pg8::Gemm g{(const bf16_t*)(ws + ACT_A), (const bf16_t*)(ws + WB_IN), NTOK, 0, 2048}; pg8::StaticOrder S; S.init(NTOK, 0, NCB, bid, 32);
        pg8::EpiInProj E{(bf16_t*)(ws + U_S5), (bf16_t*)(ws + PT_HY)}; pg8::gemm_phase(lds, g, S, E);
        return;
    }
    const int nw = G - NCB, wb = bid - NCB;
    if (NCB == 0) {
        load_tab_B(P, tab, 8); __syncthreads();
        for (int crow = wb * 8 + w; crow < NCTX; crow += nw * 8) norm_rows_B(P, P.in[2] + (size_t)crow * DM, Hn + (size_t)(NTOK + crow) * DM, tab, tab + 2048, lane);
        __syncthreads();
    }
    { const int g0 = (int)((long)wb * 2048 / nw), g1 = (int)((long)(wb + 1) * 2048 / nw); int curb = -1;
      for (int gr = g0; gr < g1; gr += 2) { const int b = gr >> 8;
          if (b != curb) { __syncthreads(); load_tab_B(P, tab, b); __syncthreads(); curb = b; }
          const bool two = (gr + 1 < g1) && (((gr + 1) >> 8) == b);
          const int row = gr * 8 + w;
          if (two) { norm_rows_B2(P, P.in[0] + (size_t)row * DM, Hn + (size_t)row * DM, tab, tab + 2048, lane); }
          else { norm_rows_B(P, P.in[0] + (size_t)row * DM, Hn + (size_t)row * DM, tab, tab + 2048, lane); gr -= 1; } }
      __syncthreads(); }
    for (int it = wb; it < 512; it += nw) {
        const int o = it >> 8, c0 = (it & 255) * 4;
        float* vals = (float*)lds_g;
        float* w3s = vals + 2048 * 8;
        float* red = w3s + 64 * 8;
        float* tot = red + 8 * 8;
        for (int idx = tid; idx < 64 * 8; idx += NTHR) { const int k = idx >> 3, col = idx & 7, dir = col >> 2, ch = col & 3; w3s[idx] = P.in[14][(size_t)k * 4096 + o * 2048 + dir * 1024 + c0 + ch]; }
        __syncthreads();
        float dec[8];
#pragma unroll
        for (int col = 0; col < 8; ++col) dec[col] = fabsf(P.in[16][(o * 2 + (col >> 2)) * 1024 + c0 + (col & 3)]);
        float sabs[8];
#pragma unroll
        for (int col = 0; col < 8; ++col) sabs[col] = 0.f;
        const float* h2f = (const float*)(ws + H2F);
        {
            float a[4][8];
#pragma unroll
            for (int r = 0; r < 4; ++r)
#pragma unroll
                for (int col = 0; col < 8; ++col) a[r][col] = 0.f;
#pragma unroll 1
            for (int k0 = 0; k0 < 64; k0 += 8) { f32x4 hv[8];
#pragma unroll
                for (int kk = 0; kk < 8; ++kk) hv[kk] = *(const f32x4*)(h2f + (size_t)(k0 + kk) * 2048 + 4 * tid);
#pragma unroll
                for (int kk = 0; kk < 8; ++kk) { const f32x4* wr4 = (const f32x4*)(w3s + (k0 + kk) * 8); const f32x4 w0 = wr4[0], w1 = wr4[1];
#pragma unroll
                    for (int r = 0; r < 4; ++r) { const float hk = hv[kk][r];
                        a[r][0] += hk * w0[0]; a[r][1] += hk * w0[1]; a[r][2] += hk * w0[2]; a[r][3] += hk * w0[3];
                        a[r][4] += hk * w1[0]; a[r][5] += hk * w1[1]; a[r][6] += hk * w1[2]; a[r][7] += hk * w1[3]; } } }
#pragma unroll
            for (int r = 0; r < 4; ++r) { const int t = 4 * tid + r; const float tn = (float)t * (1.0f / 2048.0f);
#pragma unroll
                for (int col = 0; col < 8; ++col) { a[r][col] *= expf(-tn * dec[col]); if (col < 4 || t > 0) sabs[col] += fabsf(a[r][col]); }
#pragma unroll
                for (int c4 = 0; c4 < 2; ++c4) *(f32x4*)(vals + t * 8 + 4 * c4) = (f32x4){a[r][4 * c4], a[r][4 * c4 + 1], a[r][4 * c4 + 2], a[r][4 * c4 + 3]}; }
        }
#pragma unroll
        for (int col = 0; col < 8; ++col) { const float sm = wave_sum(sabs[col]); if (lane == 0) red[w * 8 + col] = sm; }
        __syncthreads();
        if (tid < 4) { float sm = 0.f; for (int ww = 0; ww < 8; ++ww) sm += red[ww * 8 + tid] + red[ww * 8 + 4 + tid]; tot[tid] = 1.0f / (sm + 1e-6f); }
        __syncthreads();
        bf16_t* hg = (bf16_t*)(ws + HG) + (size_t)(o * 1024 + c0) * 4096;
#pragma unroll 4
        for (int idx = tid; idx < 2 * 2048 * 4; idx += NTHR) {
            const int t = idx & 2047, ch = (idx >> 11) & 3, dir = idx >> 13;
            const unsigned short v = f2bf(vals[t * 8 + dir * 4 + ch] * tot[ch]);
            if (dir == 0) hg[(size_t)ch * 4096 + 2048 - t] = v; else if (t > 0) hg[(size_t)ch * 4096 + 2048 + t] = v; else hg[(size_t)ch * 4096] = 0;
        }
        __syncthreads();
    }
}

__device__ __forceinline__ void s5_task(const Params& P, LAS unsigned char* lds, int item) {
    const int tid = threadIdx.x, w = tid >> 6, lane = tid & 63, fr = lane & 15, fq = lane >> 4;
    const int pair = item * 4 + (w >> 1), dir = w & 1, b = pair >> 6, g = pair & 63;
    unsigned char* ws = P.ws;
    LAS unsigned char* wl = lds + w * 13824;
    LAS float* BU = (LAS float*)wl;
    LAS unsigned char* X = wl + 8448;
    LAS float* tab = (LAS float*)(wl + 8448 + 4352);
    const int dg = dir * 64 + g;
    float ar, ai;
    { const double lr = (double)P.in[18][dg * 64 + lane], li = (double)P.in[19][dg * 64 + lane], dt = exp((double)P.in[20][dg]);
      const double ea = exp(lr * dt), car = ea * cos(li * dt), cai = ea * sin(li * dt);
      const double den = lr * lr + li * li; const double nr = car - 1.0, ni = cai;
      const double cr = (nr * lr + ni * li) / den, ci = (ni * lr - nr * li) / den;
      ar = (float)car; ai = (float)cai;
      tab[lane * 4 + 0] = ar; tab[lane * 4 + 1] = ai; tab[lane * 4 + 2] = (float)cr; tab[lane * 4 + 3] = (float)ci; }
    asm volatile("s_waitcnt lgkmcnt(0)" ::: "memory");
    bf16x4 Bf[8]; bf16x8 Cf[4]; float Dv[4];
#pragma unroll
    for (int j = 0; j < 8; ++j) { const int col = 16 * j + fr, pp = col >> 1, ri = col & 1; const float cr = tab[pp * 4 + 2], ci = tab[pp * 4 + 3];
        const f32x4 br = *(const f32x4*)(P.in[21] + ((size_t)dg * 64 + pp) * 16 + 4 * fq), bi = *(const f32x4*)(P.in[22] + ((size_t)dg * 64 + pp) * 16 + 4 * fq);
        float v[4];
#pragma unroll
        for (int e = 0; e < 4; ++e) v[e] = ri ? (cr * bi[e] + ci * br[e]) : (cr * br[e] - ci * bi[e]);
        const unsigned w0 = pk_bf16(v[0], v[1]), w1 = pk_bf16(v[2], v[3]);
        Bf[j][0] = (short)(w0 & 0xffff); Bf[j][1] = (short)(w0 >> 16); Bf[j][2] = (short)(w1 & 0xffff); Bf[j][3] = (short)(w1 >> 16); }
#pragma unroll
    for (int kk = 0; kk < 4; ++kk) { const int p0 = 16 * kk + 4 * fq;
        const f32x4 cr = *(const f32x4*)(P.in[23] + ((size_t)dg * 16 + fr) * 64 + p0), ci = *(const f32x4*)(P.in[24] + ((size_t)dg * 16 + fr) * 64 + p0);
#pragma unroll
        for (int e = 0; e < 4; ++e) { const unsigned wv = pk_bf16(cr[e], -ci[e]); Cf[kk][2 * e] = (short)(wv & 0xffff); Cf[kk][2 * e + 1] = (short)(wv >> 16); } }
#pragma unroll
    for (int e = 0; e < 4; ++e) Dv[e] = P.in[25][g * 16 + 4 * fq + e];
    const bf16_t* U = (const bf16_t*)(ws + U_S5) + (size_t)g * NROWS * 16 + 4 * fq;
    float* pbuf = (float*)(ws + PBUF);
    bf16_t* ypre = (bf16_t*)(ws + YPRE);
    f32x2 xs = (f32x2){0.f, 0.f}; const f32x2 arr = (f32x2){ar, ar}, aim = (f32x2){-ai, ai};
#define S5_ROW(c) ((c) < 16 ? (NTOK + b * CTX + (dir ? 255 - (16 * (c) + fr) : (16 * (c) + fr))) : (b * SEQ + (dir ? 2047 - (16 * (c) + fr - 256) : (16 * (c) + fr - 256))))
#define S5_CORE(c) \
        const u32x2 ucur = uq[i & 3]; const int row = S5_ROW(c); \
        { const int cn = ((c) + 4 < 144) ? (c) + 4 : 143; uq[i & 3] = *(const u32x2*)(U + (size_t)S5_ROW(cn) * 16); } \
        { bf16x4 Uf; Uf[0] = (short)(ucur.x & 0xffff); Uf[1] = (short)(ucur.x >> 16); Uf[2] = (short)(ucur.y & 0xffff); Uf[3] = (short)(ucur.y >> 16); \
          _Pragma("unroll") for (int j = 0; j < 8; ++j) { const f32x4 a = __builtin_amdgcn_mfma_f32_16x16x16bf16_1k(Bf[j], Uf, (f32x4){0.f, 0.f, 0.f, 0.f}, 0, 0, 0); \
            *(LAS f32x4*)(BU + fr * 132 + 16 * j + 4 * fq) = a; } } \
        asm volatile("s_waitcnt lgkmcnt(0)" ::: "memory"); \
        { f32x2 bu[16]; \
          _Pragma("unroll") for (int t = 0; t < 16; ++t) bu[t] = *(const LAS f32x2*)(BU + t * 132 + 2 * lane); \
          _Pragma("unroll") for (int t = 0; t < 16; ++t) { const f32x2 tmp = arr * xs + bu[t]; xs = aim * xs.yx + tmp; \
            *(LAS unsigned*)(X + t * 272 + 4 * lane) = pk_bf16(xs.x, xs.y); } } \
        asm volatile("s_waitcnt lgkmcnt(0)" ::: "memory");
#define S5_READOUT() \
        f32x4 y = (f32x4){0.f, 0.f, 0.f, 0.f}; \
        _Pragma("unroll") for (int kk = 0; kk < 4; ++kk) { const bf16x8 xf = *(const LAS bf16x8*)(X + fr * 272 + 64 * kk + 16 * fq); y = __builtin_amdgcn_mfma_f32_16x16x32_bf16(Cf[kk], xf, y, 0, 0, 0); } \
        const size_t oidx = (size_t)row * 1024 + g * 16 + 4 * fq;
    u32x2 uq[4]; f32x4 pq[4];
#pragma unroll
    for (int i = 0; i < 4; ++i) uq[i] = *(const u32x2*)(U + (size_t)S5_ROW(i) * 16);
#pragma unroll 1
    for (int c4 = 0; c4 < 16; c4 += 4) {
#pragma unroll
      for (int i = 0; i < 4; ++i) { const int c = c4 + i; S5_CORE(c) (void)row; }
    }
#pragma unroll 1
    for (int c4 = 16; c4 < 80; c4 += 4) {
#pragma unroll
      for (int i = 0; i < 4; ++i) { const int c = c4 + i; S5_CORE(c) S5_READOUT() *(f32x4*)(pbuf + oidx) = y; }
    }
    __builtin_amdgcn_fence(__ATOMIC_RELEASE, "workgroup"); __syncthreads(); __builtin_amdgcn_fence(__ATOMIC_ACQUIRE, "workgroup");
#pragma unroll
    for (int q = 0; q < 4; ++q) pq[q] = *(const f32x4*)(pbuf + (size_t)S5_ROW(80 + q) * 1024 + g * 16 + 4 * fq);
#pragma unroll 1
    for (int c4 = 80; c4 < 144; c4 += 4) {
#pragma unroll
      for (int i = 0; i < 4; ++i) { const int c = c4 + i; S5_CORE(c) S5_READOUT()
        const f32x4 pv = pq[i];
        { const int cn = (c + 4 < 144) ? c + 4 : 143; pq[i] = *(const f32x4*)(pbuf + (size_t)S5_ROW(cn) * 1024 + g * 16 + 4 * fq); }
        float o[4]; const float uu[4] = {bflo(ucur.x), bfhi(ucur.x), bflo(ucur.y), bfhi(ucur.y)};
#pragma unroll
        for (int e = 0; e < 4; ++e) o[e] = gelu_tanh(y[e] + pv[e] + Dv[e] * uu[e]);
        u32x2 wv; wv.x = pk_bf16(o[0], o[1]); wv.y = pk_bf16(o[2], o[3]);
        *(u32x2*)(ypre + oidx) = wv; }
    }
#undef S5_ROW
#undef S5_CORE
#undef S5_READOUT
}

constexpr int HY_G = 0, HY_GSZ = 8 * 514 * 16, HY_U = HY_GSZ, HY_ROW = 4112, HY_GATE = HY_U + 8 * HY_ROW, HY_H = HY_GATE + 8 * HY_ROW;
static_assert(HY_H + 8192 + 16 <= LDS_BYTES - 64, "hyena LDS");
struct HyRaw { u32x4 v[4]; unsigned nb[4]; };
__device__ __forceinline__ void hy_issue(const Params& P, HyRaw& r, int set, int c) {
    const int tid = threadIdx.x; const int ch = set * 1024 + c;
    const bf16_t* src = (const bf16_t*)(P.ws + PT_HY) + (size_t)ch * NTOK;
#pragma unroll
    for (int q = 0; q < 4; ++q) { const int chunk = tid + NTHR * q; const int b = chunk >> 8, t8 = (chunk & 255) * 8;
        const bf16_t* sp = src + b * SEQ + t8; r.v[q] = __builtin_nontemporal_load((const u32x4*)sp);
        const unsigned l = (t8 & 63) ? (unsigned)sp[-1] : 0u, rr = ((t8 + 8) & 63) ? (unsigned)sp[8] : 0u; r.nb[q] = l | (rr << 16); }
}
__device__ __forceinline__ void hy_commit(const Params& P, const HyRaw& r, LAS unsigned char* dstbuf, int set, int c) {
    const int tid = threadIdx.x; const int ch = set * 1024 + c;
    const float w0 = P.in[8][0 * 3072 + ch], w1 = P.in[8][1 * 3072 + ch], w2 = P.in[8][2 * 3072 + ch], bias = P.in[9][ch];
#pragma unroll
    for (int q = 0; q < 4; ++q) { const int chunk = tid + NTHR * q; const int b = chunk >> 8, t8 = (chunk & 255) * 8;
        const u32x4 raw = r.v[q];
        float x[10];
        x[1] = bflo(raw.x); x[2] = bfhi(raw.x); x[3] = bflo(raw.y); x[4] = bfhi(raw.y); x[5] = bflo(raw.z); x[6] = bfhi(raw.z); x[7] = bflo(raw.w); x[8] = bfhi(raw.w);
        x[0] = bflo(r.nb[q]); x[9] = bfhi(r.nb[q]);
        float o[8];
#pragma unroll
        for (int j = 0; j < 8; ++j) o[j] = w0 * x[j] + w1 * x[j + 1] + w2 * x[j + 2] + bias;
        u32x4 wv; wv.x = pk_bf16(o[0], o[1]); wv.y = pk_bf16(o[2], o[3]); wv.z = pk_bf16(o[4], o[5]); wv.w = pk_bf16(o[6], o[7]);
        *(LAS u32x4*)(dstbuf + b * HY_ROW + t8 * 2) = wv; }
}
__device__ __forceinline__ u32x4 hy_issue_H(const Params& P, int o, int c) { return ((const u32x4*)((const bf16_t*)(P.ws + HG) + (size_t)(o * 1024 + c) * 4096))[threadIdx.x]; }
__device__ __forceinline__ void hy_commit_H(LAS unsigned char* lds, const u32x4 h) {
    const int tid = threadIdx.x;
    *(LAS u32x4*)(lds + HY_H + 16 * tid) = h;
    if (tid == 0) *(LAS u32x4*)(lds + HY_H + 8192) = (u32x4){0u, 0u, 0u, 0u};
}
__device__ __forceinline__ void hy_build_G(LAS unsigned char* lds) {
    const int q = threadIdx.x;
    const u32x4 A = *(const LAS u32x4*)(lds + HY_H + 16 * (511 - q)), B = *(const LAS u32x4*)(lds + HY_H + 16 * (512 - q));
    const unsigned in[8] = {A.x, A.y, A.z, A.w, B.x, B.y, B.z, B.w};
#pragma unroll
    for (int cc = 0; cc < 8; ++cc) { const int e = 8 - cc; unsigned o4[4];
#pragma unroll
        for (int k = 0; k < 4; ++k) { if ((e & 1) == 0) o4[k] = in[e / 2 + k]; else o4[k] = (in[(e - 1) / 2 + k] >> 16) | (in[(e + 1) / 2 + k] << 16); }
        *(LAS u32x4*)(lds + HY_G + (cc * 514 + q) * 16) = (u32x4){o4[0], o4[1], o4[2], o4[3]}; }
}
__device__ __forceinline__ void hy_mma(LAS unsigned char* lds, f32x4 (&acc)[8]) {
    const int tid = threadIdx.x, w = tid >> 6, lane = tid & 63, fr = lane & 15, fq = lane >> 4, h = fr >> 3;
#pragma unroll
    for (int a = 0; a < 8; ++a) acc[a] = (f32x4){0.f, 0.f, 0.f, 0.f};
    LAS unsigned char* gbase = lds + HY_G + ((fr & 7) * 514 + (fr >> 3) - fq + 256 + 128 + 16 * w) * 16;
    LAS unsigned char* ub = lds + HY_U + (fr & 7) * HY_ROW + 16 * fq;
    const int hoff = h ? 0 : 32;
    const unsigned m_lo = h ? 0xffffffffu : 0u;
    const unsigned m_hi = h ? 0u : 0xffffffffu;
    bf16x8 frag[8];
#pragma unroll
    for (int a = 0; a < 8; ++a) frag[a] = *(const LAS bf16x8*)(gbase + 32 * a);
    u32x4 Bn = *(const LAS u32x4*)(ub + 64 * hoff);
#pragma unroll 1
    for (int K4 = 0; K4 < 24; ++K4) {
        const unsigned msk = (K4 < 8) ? m_lo : ((K4 >= 16) ? m_hi : 0xffffffffu);
#pragma unroll
        for (int kk = 0; kk < 4; ++kk) {
            __builtin_amdgcn_sched_barrier(0);
            const int ks = 4 * K4 + kk;
            u32x4 Bm = Bn; Bm.x &= msk; Bm.y &= msk; Bm.z &= msk; Bm.w &= msk;
            bf16x8 B; __builtin_memcpy(&B, &Bm, 16);
            Bn = *(const LAS u32x4*)(ub + 64 * ((ks + 1 + hoff) & 63));
            __builtin_amdgcn_sched_barrier(0);
#pragma unroll
            for (int a = 7; a >= 0; --a) {
                const int slot = (a - 2 * kk) & 7;
                acc[a] = __builtin_amdgcn_mfma_f32_16x16x32_bf16(frag[slot], B, acc[a], 0, 0, 0);
                if (a >= 6 && ks < 95) frag[slot] = *(const LAS bf16x8*)(gbase + 32 * ((a - 8) - 2 * ks));
            }
        }
    }
}
struct HyPre { HyRaw rv, rx; u32x4 h0; };
__device__ __forceinline__ void hy_prefetch(const Params& P, HyPre& pf, int c) { pf.h0 = hy_issue_H(P, 0, c); hy_issue(P, pf.rv, 0, c); hy_issue(P, pf.rx, 1, c); }
__device__ __forceinline__ int hyena_task(const Params& P, LAS unsigned char* lds, int c, HyPre& pf, int nxt) {
    const int tid = threadIdx.x, w = tid >> 6, lane = tid & 63, fr = lane & 15, fq = lane >> 4;
    hy_commit_H(lds, pf.h0); hy_commit(P, pf.rv, lds + HY_U, 0, c); hy_commit(P, pf.rx, lds + HY_GATE, 1, c);
    __syncthreads();
    hy_build_G(lds);
    __syncthreads();
    HyRaw r2; hy_issue(P, r2, 2, c); const u32x4 h1 = hy_issue_H(P, 1, c);
    f32x4 acc[8];
    hy_mma(lds, acc);
    const float bias0 = P.in[17][c], bias1 = P.in[17][1024 + c];
    u32x2 z1[8];
    const int bb = fr & 7, th = 1024 * (fr >> 3);
#pragma unroll
    for (int a = 0; a < 8; ++a) { const int t = th + 128 * w + 16 * a + 4 * fq;
        const u32x2 gv = *(const LAS u32x2*)(lds + HY_GATE + bb * HY_ROW + 2 * t), vv = *(const LAS u32x2*)(lds + HY_U + bb * HY_ROW + 2 * t);
        const float o0 = bflo(gv.x) * (acc[a][0] + bias0 * bflo(vv.x)), o1 = bfhi(gv.x) * (acc[a][1] + bias0 * bfhi(vv.x));
        const float o2 = bflo(gv.y) * (acc[a][2] + bias0 * bflo(vv.y)), o3 = bfhi(gv.y) * (acc[a][3] + bias0 * bfhi(vv.y));
        z1[a].x = pk_bf16(o0, o1); z1[a].y = pk_bf16(o2, o3); }
    __syncthreads();
#pragma unroll
    for (int a = 0; a < 8; ++a) { const int t = th + 128 * w + 16 * a + 4 * fq; *(LAS u32x2*)(lds + HY_U + bb * HY_ROW + 2 * t) = z1[a]; }
    hy_commit_H(lds, h1);
    hy_commit(P, r2, lds + HY_GATE, 2, c);
    __syncthreads();
    hy_build_G(lds);
    __syncthreads();
    if (nxt < 128 + 1024) hy_prefetch(P, pf, nxt - 128);
    hy_mma(lds, acc);
    bf16_t* yt = (bf16_t*)(P.ws + YT_HY) + (size_t)c * NTOK;
#pragma unroll
    for (int a = 0; a < 8; ++a) { const int t = th + 128 * w + 16 * a + 4 * fq;
        const u32x2 gv = *(const LAS u32x2*)(lds + HY_GATE + bb * HY_ROW + 2 * t); const u32x2 vv = *(const LAS u32x2*)(lds + HY_U + bb * HY_ROW + 2 * t);
        const float o0 = bflo(gv.x) * (acc[a][0] + bias1 * bflo(vv.x)), o1 = bfhi(gv.x) * (acc[a][1] + bias1 * bfhi(vv.x));
        const float o2 = bflo(gv.y) * (acc[a][2] + bias1 * bflo(vv.y)), o3 = bfhi(gv.y) * (acc[a][3] + bias1 * bfhi(vv.y));
        u32x2 wv; wv.x = pk_bf16(o0, o1); wv.y = pk_bf16(o2, o3);
        *(u32x2*)(yt + bb * SEQ + t) = wv; }
    __syncthreads();
    return nxt;
}

__device__ __forceinline__ void phaseD(const Params& P, LAS unsigned char* lds, int rep) {
    LAS int* slot = (LAS int*)(lds + LDS_BYTES - 64);
    unsigned* ctr = (unsigned*)(P.ws + CTR) + rep;
    const int bid = (int)blockIdx.x;
    if ((int)gridDim.x == 256) {
        int c0, n;
        if (bid < 128) { c0 = 2 * bid; n = 2;
#if !defined(NO_S5)
            s5_task(P, lds, bid); __syncthreads();
#endif
        } else { c0 = 256 + 6 * (bid - 128); n = 6; }
#if !defined(NO_HY)
        HyPre pf; hy_prefetch(P, pf, c0);
        for (int i = 0; i < n; ++i) (void)hyena_task(P, lds, c0 + i, pf, (i + 1 < n) ? 128 + c0 + i + 1 : (1 << 20));
#endif
    } else {
#if !defined(NO_S5)
        for (int it = bid; it < 128; it += gridDim.x) { s5_task(P, lds, it); __syncthreads(); }
#endif
#if !defined(NO_HY)
        for (int c = bid; c < 1024; c += gridDim.x) { HyPre pf; hy_prefetch(P, pf, c); (void)hyena_task(P, lds, c, pf, 1 << 20); }
#endif
    }
    (void)slot; (void)ctr;
}

__device__ __forceinline__ void hy_transpose(const Params& P, LAS unsigned char* lds) {
    const int tid = threadIdx.x, w = tid >> 6, lane = tid & 63;
    for (int it = blockIdx.x; it < 256; it += gridDim.x) {
        const int tok0 = it * 64;
        const bf16_t* yt = (const bf16_t*)(P.ws + YT_HY);
        { u32x4 raw[16]; const int tk = lane & 7;
#pragma unroll
          for (int i = 0; i < 16; ++i) { const int c = 8 * (i * 8 + w) + (lane >> 3); raw[i] = __builtin_nontemporal_load((const u32x4*)(yt + (size_t)c * NTOK + tok0 + 8 * tk)); }
#pragma unroll
          for (int i = 0; i < 16; ++i) { const int c = 8 * (i * 8 + w) + (lane >> 3); const unsigned wv[4] = {raw[i].x, raw[i].y, raw[i].z, raw[i].w};
#pragma unroll
            for (int j = 0; j < 8; ++j) { const unsigned short v = (unsigned short)((j & 1) ? (wv[j >> 1] >> 16) : (wv[j >> 1] & 0xffff)); *(LAS unsigned short*)(lds + (8 * tk + j) * 2052 + 2 * c) = v; } } }
        __syncthreads();
        bf16_t* mix = (bf16_t*)(P.ws + ACT_A);
        for (int r = 0; r < 8; ++r) { const int tok = 8 * w + r; unsigned wv[8]; float ss = 0.f;
#pragma unroll
            for (int j = 0; j < 8; ++j) { wv[j] = *(const LAS unsigned*)(lds + tok * 2052 + 32 * lane + 4 * j); const float a = bflo(wv[j]), b2 = bfhi(wv[j]); ss += a * a + b2 * b2; }
            ss = wave_sum(ss); const float rs = rsqrtf(ss * (1.0f / 1024.0f) + 1e-6f);
            const float* gp = P.in[29] + 16 * lane; unsigned ov[8];
#pragma unroll
            for (int j = 0; j < 8; ++j) ov[j] = pk_bf16(bflo(wv[j]) * rs * gp[2 * j], bfhi(wv[j]) * rs * gp[2 * j + 1]);
            bf16_t* op = mix + (size_t)(tok0 + tok) * DM + 1024 + 16 * lane;
            *(u32x4*)op = (u32x4){ov[0], ov[1], ov[2], ov[3]}; *(u32x4*)(op + 8) = (u32x4){ov[4], ov[5], ov[6], ov[7]}; }
        __syncthreads();
    }
}
__device__ __forceinline__ void s5_norm(const Params& P) {
    const int tid = threadIdx.x, w = tid >> 6, lane = tid & 63;
    bf16_t* mix = (bf16_t*)(P.ws + ACT_A);
    const float* gp = P.in[28] + 16 * lane;
    for (int row0 = (blockIdx.x * 8 + w) * 4; row0 < NTOK; row0 += gridDim.x * 32) {
        u32x4 r0[4], r1[4];
#pragma unroll
        for (int u = 0; u < 4; ++u) { const bf16_t* rp = mix + (size_t)(row0 + u) * DM + 16 * lane; r0[u] = *(const u32x4*)rp; r1[u] = *(const u32x4*)(rp + 8); }
#pragma unroll
        for (int u = 0; u < 4; ++u) { bf16_t* rp = mix + (size_t)(row0 + u) * DM + 16 * lane;
            const unsigned wv[8] = {r0[u].x, r0[u].y, r0[u].z, r0[u].w, r1[u].x, r1[u].y, r1[u].z, r1[u].w}; float ss = 0.f;
#pragma unroll
            for (int j = 0; j < 8; ++j) { const float a = bflo(wv[j]), b2 = bfhi(wv[j]); ss += a * a + b2 * b2; }
            ss = wave_sum(ss); const float rs = rsqrtf(ss * (1.0f / 1024.0f) + 1e-6f);
            unsigned ov[8];
#pragma unroll
            for (int j = 0; j < 8; ++j) ov[j] = pk_bf16(bflo(wv[j]) * rs * gp[2 * j], bfhi(wv[j]) * rs * gp[2 * j + 1]);
            *(u32x4*)rp = (u32x4){ov[0], ov[1], ov[2], ov[3]}; *(u32x4*)(rp + 8) = (u32x4){ov[4], ov[5], ov[6], ov[7]}; }
    }
}
template <int MODE> __device__ __forceinline__ void row_norm(const Params& P) {
    const int tid = threadIdx.x, w = tid >> 6, lane = tid & 63;
    const float* modf = (const float*)(P.ws + MODF);
    bf16_t* h2 = (bf16_t*)(P.ws + ACT_A);
    constexpr int NR = 4;
    for (int row0 = (blockIdx.x * 8 + w) * NR; row0 < NTOK; row0 += gridDim.x * 8 * NR) {
        u32x2 raw[NR][8];
#pragma unroll
        for (int u = 0; u < NR; ++u) { const bf16_t* xb = (const bf16_t*)(P.ws + PBUF) + (size_t)(row0 + u) * DM;
#pragma unroll
            for (int q = 0; q < 8; ++q) raw[u][q] = *(const u32x2*)(xb + 4 * (lane + 64 * q)); }
#pragma unroll
        for (int u = 0; u < NR; ++u) { const int row = row0 + u; float* xr = P.out + (size_t)row * DM; const int b = row >> 11;
            f32x4 v[8]; float ss = 0.f;
#pragma unroll
            for (int q = 0; q < 8; ++q) { const u32x2 rb = raw[u][q]; v[q] = (f32x4){bflo(rb.x), bfhi(rb.x), bflo(rb.y), bfhi(rb.y)}; ss += v[q][0] * v[q][0] + v[q][1] * v[q][1] + v[q][2] * v[q][2] + v[q][3] * v[q][3]; }
            ss = wave_sum(ss); const float r = rsqrtf(ss * (1.0f / DM) + 1e-6f);
#pragma unroll
            for (int q = 0; q < 8; ++q) { const int c0 = 4 * (lane + 64 * q);
                if (MODE == 0) { const f32x4 g = *(const f32x4*)(P.in[31] + c0); const f32x4 sh = *(const f32x4*)(modf + (size_t)b * 12288 + 3 * 2048 + c0), sc = *(const f32x4*)(modf + (size_t)b * 12288 + 4 * 2048 + c0);
                    float o[4];
#pragma unroll
                    for (int e = 0; e < 4; ++e) o[e] = (v[q][e] * r * g[e]) * (1.0f + sc[e]) + sh[e];
                    u32x2 wv; wv.x = pk_bf16(o[0], o[1]); wv.y = pk_bf16(o[2], o[3]); *(u32x2*)(h2 + (size_t)row * DM + c0) = wv; }
                else { const f32x4 g = *(const f32x4*)(P.in[35] + c0); __builtin_nontemporal_store(v[q] * r * g, (f32x4*)(xr + c0)); } } }
    }
}

__global__ void __launch_bounds__(NTHR, 2) mega(Params P) {
    extern __shared__ __attribute__((aligned(16))) unsigned char lds_raw[];
    LAS unsigned char* lds = (LAS unsigned char*)lds_raw;
    cg::grid_group grid = cg::this_grid();
    unsigned char* ws = P.ws;
    const int lo = P.ph_lo, hi = P.ph_hi, G = gridDim.x, bid = blockIdx.x;
#ifndef PHMASK
#define PHMASK 0x7ff
#endif
#define IN(k) (((PHMASK >> (k)) & 1) && lo <= (k) && (k) < hi)
    { volatile LAS unsigned* stw = (volatile LAS unsigned*)(lds + LDS_BYTES - 32); if (threadIdx.x < 4) stw[threadIdx.x] = 0u; }
    __syncthreads();
    XcdBarrier xbar = xcd_barrier_post((unsigned*)(ws + WS_BAR), (volatile LAS unsigned*)(lds + LDS_BYTES - 32));
    if (P.ph_hi > 1000) grid.sync();
#define SEAM(k) do { if (IN(k) && IN((k) + 1)) xcd_barrier(xbar); } while (0)
#ifndef DUPMASK
#define DUPMASK 0
#endif
#define DUP(k) ((DUPMASK >> (k)) & 1)
    if (IN(0)) { phaseA(P, lds_raw); if (DUP(0)) { __syncthreads(); phaseA(P, lds_raw); } }
    SEAM(0);
    if (IN(1)) { phaseB(P, lds_raw, lds); if (DUP(1)) { __syncthreads(); phaseB(P, lds_raw, lds); } }
    SEAM(1);
    if (IN(2)) { pg8::Gemm g{(const bf16_t*)(ws + ACT_A), (const bf16_t*)(ws + WB_IN), NTOK, 4096, 2048}; pg8::StaticOrder S; S.init(NTOK, 4096, G, bid, (G >= 64) ? 0 : 32);
        pg8::EpiInProj E{(bf16_t*)(ws + U_S5), (bf16_t*)(ws + PT_HY)}; pg8::gemm_phase(lds, g, S, E); }
    SEAM(2);
    if (IN(3)) { phaseD(P, lds, 0); if (DUP(3)) { __syncthreads(); phaseD(P, lds, 1); } }
    SEAM(3);
    if (IN(4)) { pg8::Gemm g{(const bf16_t*)(ws + YPRE), (const bf16_t*)(ws + WB_GLU), NTOK, 2048, 1024}; pg8::StaticOrder S; S.init(NTOK, 2048, G, bid, 0);
        pg8::EpiGate<0> E{(bf16_t*)(ws + ACT_A), DM, P.in[27], 1024};
        const bool tfirst = ((bid >> 3) & 1) != 0;
        if (tfirst) hy_transpose(P, lds);
        pg8::gemm_phase(lds, g, S, E);
        if (!tfirst) hy_transpose(P, lds); }
    SEAM(4);
    if (IN(5)) s5_norm(P);
    SEAM(5);
    if (IN(6)) { pg8::Gemm g{(const bf16_t*)(ws + ACT_A), (const bf16_t*)(ws + WB_OUT), NTOK, 2048, 2048}; pg8::StaticOrder S; S.init(NTOK, 2048, G, bid, 0);
        pg8::EpiRes<false> E{P.in[0], (bf16_t*)(ws + PBUF), (const float*)(ws + MODF) + 2 * 2048}; pg8::gemm_phase(lds, g, S, E); }
    SEAM(6);
    if (IN(7)) row_norm<0>(P);
    SEAM(7);
    if (IN(8)) { pg8::Gemm g{(const bf16_t*)(ws + ACT_A), (const bf16_t*)(ws + WB_GU), NTOK, 11264, 2048}; pg8::StaticOrder S; S.init(NTOK, 11264, G, bid, 0);
        pg8::EpiGate<1> E{(bf16_t*)(ws + HID), DFF, nullptr, 0}; pg8::gemm_phase(lds, g, S, E); }
    SEAM(8);
    if (IN(9)) { pg8::Gemm g{(const bf16_t*)(ws + HID), (const bf16_t*)(ws + WB_DN), NTOK, 2048, DFF}; pg8::StaticOrder S; S.init(NTOK, 2048, G, bid, 0);
        pg8::EpiRes<true> E{(const void*)(ws + PBUF), (bf16_t*)(ws + PBUF), (const float*)(ws + MODF) + 5 * 2048}; pg8::gemm_phase(lds, g, S, E); }
    SEAM(9);
    if (IN(10)) row_norm<1>(P);
}

extern "C" void kernel_launch(void* const* d_in, const int* in_sizes, int n_in, void* d_out, int out_size, void* d_ws, size_t ws_size, hipStream_t stream) {
    static int grid_blocks = 0;
    if (!grid_blocks) {
        int dev = 0, cus = 0, per_cu = 0;
        hipGetDevice(&dev);
        hipDeviceGetAttribute(&cus, hipDeviceAttributeMultiprocessorCount, dev);
        if (hipFuncSetAttribute((const void*)mega, hipFuncAttributeMaxDynamicSharedMemorySize, LDS_BYTES) != hipSuccess) fprintf(stderr, "hipFuncSetAttribute failed\n");
        hipOccupancyMaxActiveBlocksPerMultiprocessor(&per_cu, (const void*)mega, NTHR, LDS_BYTES);
        if (per_cu < 1) { fprintf(stderr, "occupancy query says %d\n", per_cu); per_cu = 1; }
        (void)hipGetLastError();
        grid_blocks = cus * per_cu;
        if (ws_size < WS_END) fprintf(stderr, "workspace too small: %zu < %zu\n", ws_size, (size_t)WS_END);
        if (n_in != 36) fprintf(stderr, "unexpected n_in %d\n", n_in);
    }
    Params p{};
    for (int i = 0; i < 36; ++i) p.in[i] = (const float*)d_in[i];
    p.out = (float*)d_out; p.ws = (unsigned char*)d_ws;
#if ONE_LAUNCH
    (void)hipMemsetAsync((unsigned char*)d_ws + WS_BAR, 0, (size_t)XCD_BAR_WORDS * 4, stream);
    p.ph_lo = 0; p.ph_hi = NPHASE;
    void* args[] = {&p};
    hipError_t e = hipLaunchCooperativeKernel((const void*)mega, dim3(grid_blocks), dim3(NTHR), args, LDS_BYTES, stream);
    if (e != hipSuccess) fprintf(stderr, "cooperative launch failed: %s (grid %d)\n", hipGetErrorString(e), grid_blocks);
#else
    for (int ph = 0; ph < NPHASE; ++ph) { p.ph_lo = ph; p.ph_hi = ph + 1; hipLaunchKernelGGL(mega, dim3(grid_blocks), dim3(NTHR), LDS_BYTES, stream, p); }
#endif
}
```
